# Optimizing an MI355X kernel written in HIP

```python
import jax
import jax.numpy as jnp
from jax import lax
import numpy as np

D_MODEL = 1024
BATCH = 16
SEQ = 256
DEPTH = 4
DEC_BATCH = 8
DEC_SEQ = 2048
PAST_LEN = 512

GRID_W = 64
EPS = 1e-6
NEG_INF = -1e30
BRANCH_W = D_MODEL // 2
N_BRANCH = 3
CONV_K = 3
NA_HEADS = 8
NA_HD = BRANCH_W // NA_HEADS
WIN_R = 8
WIN_C = 16
QCB = 16
KC = 2 * WIN_C
NCB = GRID_W // QCB
ATT_BLOCK = 128
GLA_HEADS = 4
GLA_DV = BRANCH_W // GLA_HEADS
GLA_DK = GLA_DV // 2
GLA_KW = GLA_HEADS * GLA_DK
GLA_RANK = 16
GLA_TAU = 16.0
GLA_CHUNK = 64
ROPE_BASE = 10000.0
SPLIT_SIZES = (BRANCH_W, BRANCH_W, BRANCH_W, BRANCH_W,
               BRANCH_W, BRANCH_W, BRANCH_W, BRANCH_W,
               GLA_KW, GLA_KW, BRANCH_W, BRANCH_W, GLA_RANK, GLA_RANK)
D_IN = sum(SPLIT_SIZES)
SPLIT_IDX = tuple(int(i) for i in np.cumsum(SPLIT_SIZES)[:-1])

kernel_name = 'hybrid_conv_natten_gla_diffusion_step'


def rms_norm(x, g):
    xf = x.astype(jnp.float32)
    y = xf * lax.rsqrt(jnp.mean(xf * xf, axis=-1, keepdims=True) + EPS)
    return (y * g.astype(jnp.float32)).astype(x.dtype)


def to_heads(u, n_heads):
    b, t, _ = u.shape
    return u.reshape(b, t, n_heads, -1).transpose(0, 2, 1, 3)


def from_heads(u):
    b, h, t, d = u.shape
    return u.transpose(0, 2, 1, 3).reshape(b, t, h * d)


def adaln(cond, w_ada, b_ada):
    m = jax.nn.silu(cond) @ w_ada + b_ada
    if m.ndim == 2:
        m = m[:, None, :]
    return jnp.split(m, 3, axis=-1)


def short_conv(u, w):
    t = u.shape[1]
    pad = CONV_K // 2
    up = jnp.pad(u, ((0, 0), (pad, pad), (0, 0)))
    y = up[:, 0:t] * w[0]
    for i in range(1, CONV_K):
        y = y + up[:, i:i + t] * w[i]
    return y


def rope_2d(x):
    t = x.shape[2]
    pos = np.arange(t)
    n_f = GLA_DK // 4
    inv = ROPE_BASE ** (-np.arange(n_f) / n_f)
    ang_r = jnp.asarray((pos // GRID_W)[:, None] * inv, jnp.float32)
    ang_c = jnp.asarray((pos % GRID_W)[:, None] * inv, jnp.float32)

    def rot(u, ang):
        a, b = jnp.split(u, 2, axis=-1)
        cos, sin = jnp.cos(ang), jnp.sin(ang)
        return jnp.concatenate([a * cos - b * sin, a * sin + b * cos], axis=-1)

    xf = x.astype(jnp.float32)
    half = GLA_DK // 2
    return jnp.concatenate([rot(xf[..., :half], ang_r), rot(xf[..., half:], ang_c)], axis=-1).astype(x.dtype)


def na_context(q, k, v):
    b, h, t, d = q.shape
    nb = t // ATT_BLOCK
    qb = q.reshape(b, h, nb, ATT_BLOCK, d).transpose(2, 0, 1, 3, 4)

    def block(qi):
        s = jnp.einsum('bhqd,bhkd->bhqk', qi, k).astype(jnp.float32) * NA_HD ** -0.5
        p = jax.nn.softmax(s, axis=-1).astype(v.dtype)
        return jnp.einsum('bhqk,bhkd->bhqd', p, v)

    o = lax.map(block, qb)
    return o.transpose(1, 2, 0, 3, 4).reshape(b, h, t, d)


def na_latent(q, k, v, k_ctx, v_ctx, rpb):
    b, h, t, d = q.shape
    rows = t // GRID_W
    kr = min(WIN_R, rows)
    r = np.arange(rows)
    rs = np.clip(r - kr // 2, 0, rows - kr)
    row_idx = rs[:, None] + np.arange(kr)
    dr = row_idx - r[:, None]
    kcs = np.clip(np.arange(NCB) * QCB - WIN_C // 2, 0, GRID_W - KC)
    col_idx = kcs[:, None] + np.arange(KC)
    qcol = np.arange(GRID_W).reshape(NCB, QCB)
    cs = np.clip(qcol - WIN_C // 2, 0, GRID_W - WIN_C)
    kcol = col_idx[:, None, :]
    mask = (kcol >= cs[..., None]) & (kcol < cs[..., None] + WIN_C)
    dc = np.clip(kcol - qcol[..., None] + WIN_C - 1, 0, 2 * WIN_C - 2)
    key_idx = (row_idx[:, None, :, None] * GRID_W + col_idx[None, :, None, :]).reshape(rows, NCB, kr * KC)
    nw = kr * KC

    bias = rpb[:, (dr + WIN_R - 1)[:, None, None, :, None], dc[None, :, :, None, :]].astype(jnp.float32)
    bias = jnp.where(mask[None, None, :, :, None, :], bias, NEG_INF).reshape(h, rows, NCB, QCB, nw)

    qg = q.reshape(b, h, rows, NCB, QCB, d)
    kw = jnp.take(k, key_idx, axis=2)
    vw = jnp.take(v, key_idx, axis=2)
    scale = NA_HD ** -0.5
    s_win = jnp.einsum('bhrjid,bhrjmd->bhrjim', qg, kw).astype(jnp.float32) * scale + bias
    s_ctx = jnp.einsum('bhrjid,bhnd->bhrjin', qg, k_ctx).astype(jnp.float32) * scale
    p = jax.nn.softmax(jnp.concatenate([s_win, s_ctx], axis=-1), axis=-1).astype(v.dtype)
    o = (jnp.einsum('bhrjim,bhrjmd->bhrjid', p[..., :nw], vw)
         + jnp.einsum('bhrjin,bhnd->bhrjid', p[..., nw:], v_ctx))
    return o.reshape(b, h, t, d)


def gla_chunked(q, k, v, log_a, s0):
    b, h, t, dk = q.shape
    dv = v.shape[-1]
    n = t // GLA_CHUNK

    def chunks(u):
        return u.astype(jnp.float32).reshape(b, h, n, GLA_CHUNK, u.shape[-1]).transpose(2, 0, 1, 3, 4)

    lower = jnp.tril(jnp.ones((GLA_CHUNK, GLA_CHUNK), dtype=bool))[:, :, None]

    def step(s, inp):
        qc, kc, vc, lc = inp
        bc = jnp.cumsum(lc, axis=2)
        o_inter = jnp.einsum('bhtk,bhkv->bhtv', qc * jnp.exp(bc), s)
        diff = bc[:, :, :, None, :] - bc[:, :, None, :, :]
        decay = jnp.where(lower, jnp.exp(jnp.where(lower, diff, 0.0)), 0.0)
        att = jnp.einsum('bhtk,bhsk,bhtsk->bhts', qc, kc, decay)
        o = o_inter + jnp.einsum('bhts,bhsv->bhtv', att, vc)
        b_last = bc[:, :, -1, :]
        s_new = (jnp.exp(b_last)[..., None] * s
                 + jnp.einsum('bhsk,bhsv->bhkv', kc * jnp.exp(b_last[:, :, None, :] - bc), vc))
        return s_new, o

    s_fin, o = lax.scan(step, s0.astype(jnp.float32), (chunks(q), chunks(k), chunks(v), chunks(log_a)))
    return o.transpose(1, 2, 0, 3, 4).reshape(b, h, t, dv), s_fin


def gla_bidir(q, k, v, la_f, la_b, s_f0, s_b0):
    o_f, s_f = gla_chunked(q, k, v, la_f, s_f0)
    flip = lambda u: jnp.flip(u, axis=2)
    o_b, s_b = gla_chunked(flip(q), flip(k), flip(v), flip(la_b), s_b0)
    return o_f + flip(o_b), s_f, s_b


def log_decay(lr, w, b):
    z = (lr @ w + b).astype(jnp.float32)
    return to_heads(jax.nn.log_sigmoid(z) / GLA_TAU, GLA_HEADS)


def trunk_layer(x, mod, ctx, P):
    shift, scale, gate = mod
    h = rms_norm(x, P['norm_w']) * (1.0 + scale) + shift
    (xa, ba, ca, ga, qn, kn, vn, gn, qg, kg, vg, gg, lrf, lrb) = jnp.split(h @ P['w_in'], SPLIT_IDX, axis=-1)

    y_conv = ba * short_conv(ca * xa, P['conv_w']) * jax.nn.silu(ga)

    q = rms_norm(to_heads(qn, NA_HEADS), P['q_norm_w'])
    k = rms_norm(to_heads(kn, NA_HEADS), P['k_norm_w'])
    v = to_heads(vn, NA_HEADS)

    qc = to_heads(qg, GLA_HEADS)
    kc = to_heads(kg, GLA_HEADS)
    vc = to_heads(vg, GLA_HEADS)
    la_f = log_decay(lrf, P['w_alpha'][0], P['b_alpha'][0])
    la_b = log_decay(lrb, P['w_alpha'][1], P['b_alpha'][1])

    if ctx is None:
        o_na = na_context(q, k, v)
        zeros = jnp.zeros((x.shape[0], GLA_HEADS, GLA_DK, GLA_DV), jnp.float32)
        s_f0, s_b0 = zeros, zeros
    else:
        k_ctx, v_ctx, s_f0, s_b0 = ctx
        o_na = na_latent(q, k, v, k_ctx, v_ctx, P['rpb'])
        qc = rope_2d(qc)
        kc = rope_2d(kc)

    o_gla, s_f, s_b = gla_bidir(qc * GLA_DK ** -0.5, kc, vc, la_f, la_b, s_f0, s_b0)

    y_na = from_heads(o_na) * jax.nn.silu(gn)
    y_gla = from_heads(rms_norm(o_gla, P['gla_norm_w'])).astype(x.dtype) * jax.nn.silu(gg)

    g_conv, g_na, g_gla = jnp.split(jax.nn.sigmoid(h @ P['w_gate'] + P['b_gate']), N_BRANCH, axis=-1)
    wb = P['w_branch']
    merged = g_conv * (y_conv @ wb[0]) + g_na * (y_na @ wb[1]) + g_gla * (y_gla @ wb[2])
    x_new = x + gate * (merged @ P['w_out'])
    return x_new, (k, v, s_f, s_b)


def setup_inputs(seed: int = 0) -> dict:
    key = jax.random.key(seed)
    ks = jax.random.split(key, 24)
    f32 = jnp.float32

    def nrm(k, shape, s):
        return jax.random.normal(k, shape, f32) * s

    return {
        'x_prompt': nrm(ks[0], (BATCH, SEQ, D_MODEL), 1.0),
        'x_sample': nrm(ks[1], (DEC_BATCH, DEC_SEQ, D_MODEL), 1.0),
        'c': nrm(ks[2], (DEC_BATCH, D_MODEL), 1.0),
        'cache_k': nrm(ks[3], (DEC_BATCH, DEPTH, NA_HEADS, PAST_LEN, NA_HD), 1.0),
        'cache_v': nrm(ks[4], (DEC_BATCH, DEPTH, NA_HEADS, PAST_LEN, NA_HD), 1.0),
        'state_fwd': nrm(ks[5], (DEC_BATCH, DEPTH, GLA_HEADS, GLA_DK, GLA_DV), 0.5),
        'state_bwd': nrm(ks[6], (DEC_BATCH, DEPTH, GLA_HEADS, GLA_DK, GLA_DV), 0.5),
        'c_ctx': nrm(ks[7], (D_MODEL,), 1.0),
        'norm_w': 1.0 + nrm(ks[8], (DEPTH, D_MODEL), 0.01),
        'w_ada': nrm(ks[9], (DEPTH, D_MODEL, 3 * D_MODEL), D_MODEL ** -0.5),
        'b_ada': nrm(ks[10], (DEPTH, 3 * D_MODEL), 0.02),
        'w_in': nrm(ks[11], (DEPTH, D_MODEL, D_IN), D_MODEL ** -0.5),
        'conv_w': nrm(ks[12], (DEPTH, CONV_K, BRANCH_W), CONV_K ** -0.5),
        'q_norm_w': 1.0 + nrm(ks[13], (DEPTH, NA_HD), 0.01),
        'k_norm_w': 1.0 + nrm(ks[14], (DEPTH, NA_HD), 0.01),
        'rpb': nrm(ks[15], (DEPTH, NA_HEADS, 2 * WIN_R - 1, 2 * WIN_C - 1), 0.1),
        'w_alpha': nrm(ks[16], (DEPTH, 2, GLA_RANK, GLA_KW), GLA_RANK ** -0.5),
        'b_alpha': nrm(ks[17], (DEPTH, 2, GLA_KW), 0.1),
        'gla_norm_w': 1.0 + nrm(ks[18], (DEPTH, GLA_DV), 0.01),
        'w_branch': nrm(ks[19], (DEPTH, N_BRANCH, BRANCH_W, D_MODEL), BRANCH_W ** -0.5),
        'w_gate': nrm(ks[20], (DEPTH, D_MODEL, N_BRANCH * D_MODEL), D_MODEL ** -0.5),
        'b_gate': nrm(ks[21], (DEPTH, N_BRANCH * D_MODEL), 0.02),
        'w_out': nrm(ks[22], (DEPTH, D_MODEL, D_MODEL), D_MODEL ** -0.5),
    }


def reference(x_prompt, x_sample, c, cache_k, cache_v, state_fwd, state_bwd, c_ctx,
              norm_w, w_ada, b_ada, w_in, conv_w, q_norm_w, k_norm_w, rpb,
              w_alpha, b_alpha, gla_norm_w, w_branch, w_gate, b_gate, w_out):
    y_p = x_prompt
    y_s = x_sample
    ks, vs, sfs, sbs = [], [], [], []
    for l in range(DEPTH):
        P = {
            'norm_w': norm_w[l], 'w_in': w_in[l], 'conv_w': conv_w[l],
            'q_norm_w': q_norm_w[l], 'k_norm_w': k_norm_w[l], 'rpb': rpb[l],
            'w_alpha': w_alpha[l], 'b_alpha': b_alpha[l], 'gla_norm_w': gla_norm_w[l],
            'w_branch': w_branch[l], 'w_gate': w_gate[l], 'b_gate': b_gate[l], 'w_out': w_out[l],
        }
        mod_ctx = adaln(c_ctx, w_ada[l], b_ada[l])
        y_p, (k_l, v_l, sf_l, sb_l) = trunk_layer(y_p, mod_ctx, None, P)
        ks.append(k_l)
        vs.append(v_l)
        sfs.append(sf_l)
        sbs.append(sb_l)
        mod_lat = adaln(c, w_ada[l], b_ada[l])
        ctx = (cache_k[:, l], cache_v[:, l], state_fwd[:, l], state_bwd[:, l])
        y_s, _ = trunk_layer(y_s, mod_lat, ctx, P)
    return (y_p, y_s, jnp.stack(ks, axis=1), jnp.stack(vs, axis=1), jnp.stack(sfs, axis=1), jnp.stack(sbs, axis=1))
```

```cpp
#include <hip/hip_runtime.h>
#include <cstdio>
#include <cstdint>
#ifndef DBG_SCALE
#define DBG_SCALE 1.0f
#endif
#ifndef DBG_SCALE_ST
#define DBG_SCALE_ST 1.0f
#endif
constexpr int DM = 1024, DEPTH = 4, NB_CTX = 16, T_CTX = 256, NB_LAT = 8, T_LAT = 2048, PAST = 512;
constexpr int M_CTX = NB_CTX * T_CTX, M_LAT = NB_LAT * T_LAT, MROWS = M_CTX + M_LAT;
constexpr int NT1 = 35, N1 = NT1 * 256;
constexpr int TILE_LR = 22, TILE_GATE0 = 23;
constexpr int NMOD = 9;
constexpr float EPS = 1e-6f, LOG2E = 1.4426950408889634f;
constexpr size_t OUT_X = 0, OUT_CK = 20971520, OUT_CV = 29360128, OUT_SF = 37748736, OUT_SB = 39845888, OUT_TOTAL = 41943040;
constexpr size_t MiB = 1u << 20;
constexpr size_t WS_CTL = 0, CTL_ZERO_BYTES = 1 * MiB;
constexpr size_t WS_MODP = 1 * MiB;
constexpr size_t WS_WEFF = 5 * MiB;
constexpr size_t WS_GATEM = 5 * MiB + 256 * 1024;
constexpr size_t WS_BIASV = 6 * MiB;
constexpr size_t WS_SSP = 8 * MiB;
constexpr size_t WS_WB1 = 10 * MiB;
constexpr size_t WS_WB2 = 80 * MiB;
constexpr size_t WS_WB3 = 92 * MiB;
constexpr size_t WS_CKB = 100 * MiB, WS_CVB = 116 * MiB;
constexpr size_t WS_AP = 132 * MiB;
constexpr size_t WS_CONVIN = 172 * MiB;
constexpr size_t WS_NA = 252 * MiB;
constexpr size_t WS_G = 332 * MiB;
constexpr size_t WS_LR = 392 * MiB;
constexpr size_t WS_Y = 396 * MiB;
constexpr size_t WS_GATES = WS_CONVIN;
constexpr size_t WS_MERGED = WS_G;
constexpr size_t WS_END = 456 * MiB;
static_assert(WS_GATES + (size_t)MROWS * 3072 * 2 <= WS_G && WS_MERGED + (size_t)MROWS * 1024 * 2 <= WS_LR && WS_Y + (size_t)MROWS * 1536 * 2 <= WS_END, "ws map");
constexpr int CW_BAR = 4096;
constexpr int RING_BYTES = 131072, LDSCTL_OFF = RING_BYTES, MISC_OFF = LDSCTL_OFF + 320, LDS_BYTES = 147456;

#define GAS __attribute__((address_space(1)))
#define LAS __attribute__((address_space(3)))
typedef unsigned short bf16;
typedef unsigned v4u __attribute__((ext_vector_type(4)));
typedef unsigned v2u __attribute__((ext_vector_type(2)));
typedef float f32x4 __attribute__((ext_vector_type(4)));
typedef float f32x16 __attribute__((ext_vector_type(16)));
typedef short bf16x8 __attribute__((ext_vector_type(8)));
typedef short s16x4 __attribute__((ext_vector_type(4)));
typedef GAS unsigned gu32;
#define RLX_AGENT __ATOMIC_RELAXED, __HIP_MEMORY_SCOPE_AGENT
#define LDS_WAIT() asm volatile("s_waitcnt lgkmcnt(0)" ::: "memory")
#define VM_WAIT() asm volatile("s_waitcnt vmcnt(0)" ::: "memory")
__device__ __forceinline__ unsigned f2bf(float f) { unsigned u = __builtin_bit_cast(unsigned, f); return (u + 0x7fffu + ((u >> 16) & 1u)) >> 16; }
__device__ __forceinline__ unsigned pk2(float lo, float hi) { return f2bf(lo) | (f2bf(hi) << 16); }
__device__ __forceinline__ float bflo(unsigned w) { return __builtin_bit_cast(float, w << 16); }
__device__ __forceinline__ float bfhi(unsigned w) { return __builtin_bit_cast(float, w & 0xffff0000u); }
__device__ __forceinline__ float fsigmoid(float x) { return __builtin_amdgcn_rcpf(1.f + __expf(-x)); }
__device__ __forceinline__ float fsilu(float x) { return x * fsigmoid(x); }

__host__ __device__ __forceinline__ void wb1_src(int nidx, int& mat, int& col) {
    const int tile = nidx >> 8, s = nidx & 255, bj = s >> 7, wc = (s >> 5) & 3, nn = (s >> 4) & 1, fq = (s >> 2) & 3, j = s & 3;
    const int pcol = 128 * bj + 32 * wc + 8 * fq + 4 * nn + j;
    mat = 0;
    if (tile < 8) col = 256 * tile + pcol;
    else if (tile < 12) col = (tile < 10 ? 2048 : 2560) + 64 * (4 * (tile & 1) + wc) + 32 * bj + 8 * fq + 4 * nn + j;
    else if (tile < 16) col = 3072 + 256 * (tile - 12) + pcol;
    else if (tile < 18) col = 4096 + 256 * (tile - 16) + 64 * wc + 32 * bj + 16 * nn + 4 * fq + j;
    else if (tile < 22) col = 4608 + 256 * (tile - 18) + pcol;
    else if (tile == TILE_LR) { if (s < 32) col = 5632 + s; else { mat = -1; col = 0; } }
    else { mat = 1; col = 256 * (tile - TILE_GATE0) + pcol; }
}
__host__ __device__ __forceinline__ int pcol_of_slot(int s) { const int bj = s >> 7, wc = (s >> 5) & 3, nn = (s >> 4) & 1, fq = (s >> 2) & 3, j = s & 3; return 128 * bj + 32 * wc + 8 * fq + 4 * nn + j; }


namespace pg8 {
#define PG8_LAS __attribute__((address_space(3)))
typedef unsigned short bf16_t;
typedef short bf16x8 __attribute__((ext_vector_type(8)));
typedef float f32x4 __attribute__((ext_vector_type(4)));
typedef unsigned u32x4 __attribute__((ext_vector_type(4)));
constexpr int BM = 256, BK = 64, HALF = 128, HTB = HALF * BK * 2  , STAGE_BYTES = 8 * HTB, NXCD = 8, WGM = 8;

__host__ __device__ __forceinline__ int lds_byte(int r, int c) { const int st = (r >> 4) * 2 + (c >> 5), rr = r & 15, cc = c & 31, ob = rr * 64 + cc * 2; return st * 1024 + (ob ^ (((ob >> 9) & 1) << 5)); }
__host__ __device__ __forceinline__ void stage_rc(int b, int& R, int& C) { const int st = b / 1024, sb = b % 1024, swz = sb ^ (((sb >> 9) & 1) << 5); R = (st >> 1) * 16 + swz / 64; C = (st & 1) * 32 + (swz % 64) / 2; }
__host__ __device__ __forceinline__ int perm32(int rho) { const int n = rho >> 4, i = rho & 15; return 8 * (i >> 2) + 4 * n + (i & 3); }

struct Unit { int pm, pn; };
struct Gemm { const bf16_t* A; const bf16_t* Bt; int M, N, K; };

struct StaticOrder {
    int nM, nN, nwg, G, c;
    __host__ __device__ void init(int M, int N, int G_, int c_) { nM = M / BM; nN = N / BM; nwg = nM * nN; G = G_; c = c_; }
    __host__ __device__ bool next(int i, Unit& u) const {
        const long L = (long)i * G + c; if (L >= nwg) return false;
        int wgid = (int)L; { const int q = nwg / NXCD, r = nwg % NXCD, xcd = wgid % NXCD, off = wgid / NXCD; wgid = (xcd < r ? xcd * (q + 1) : r * (q + 1) + (xcd - r) * q) + off; }
        const int nig = WGM * nN, gid = wgid / nig, fm = gid * WGM, gsz = (nM - fm) < WGM ? (nM - fm) : WGM;
        u.pm = fm + ((wgid % nig) % gsz); u.pn = (wgid % nig) / gsz; return true;
    }
    __device__ __forceinline__ void a_ready(const Unit&) const {}
    __device__ __forceinline__ void done(const Unit&) const {}
};


__device__ __forceinline__ unsigned cvt_pk_bf16(float lo, float hi) { unsigned r; asm volatile("v_cvt_pk_bf16_f32 %0, %1, %2" : "=v"(r) : "v"(lo), "v"(hi)); return r; }
typedef unsigned u32x2 __attribute__((ext_vector_type(2)));

struct EpiG1 {
    static constexpr bool PERM = false, AFTER_DRAIN = false, MID = false; static constexpr int MID_T0 = 0, MID_T1 = 0;
    int layer, tile0;
    unsigned char* wsb; float* outb;
    const float *qnw, *knw;
    __device__ __forceinline__ void operator()(const f32x4 (&acc)[2][2][4][2], const Unit& u, int wr, int wc, int fr, int fq) const {
        const float* ssp = (const float*)(wsb + WS_SSP); const float* biasv = (const float*)(wsb + WS_BIASV) + (size_t)layer * NMOD * N1;
        bf16_t* convin = (bf16_t*)(wsb + WS_CONVIN); bf16_t* na = (bf16_t*)(wsb + WS_NA); bf16_t* g = (bf16_t*)(wsb + WS_G); bf16_t* gates = (bf16_t*)(wsb + WS_GATES); float* lr = (float*)(wsb + WS_LR);
        float* out_ck = outb + OUT_CK; float* out_cv = outb + OUT_CV;
        const int tile = tile0 + u.pn;
        const int bi = u.pm < 16 ? 0 : 1 + ((u.pm - 16) >> 3);
        int rowb = u.pm * BM + wr * 64 + fr; asm volatile("" : "+v"(rowb));
        f32x4 bv[2][2];
#pragma unroll
        for (int bj = 0; bj < 2; ++bj)
#pragma unroll
            for (int n = 0; n < 2; ++n) bv[bj][n] = *(const f32x4*)(biasv + (size_t)bi * N1 + tile * 256 + 128 * bj + 32 * wc + 16 * n + 4 * fq);
#define G1_RINV(r) ({ const f32x4 p_ = *(const f32x4*)(ssp + (size_t)(r) * 16 + 4 * fq); float s_ = (p_[0] + p_[1]) + (p_[2] + p_[3]); s_ += __shfl_xor(s_, 16); s_ += __shfl_xor(s_, 32); __builtin_amdgcn_rsqf(s_ * (1.0f / 1024.0f) + EPS); })
        if (tile < 8 || (tile >= 12 && tile < 16) || (tile >= 18 && tile < 22) || tile >= TILE_GATE0) {
            bf16_t* dst; int pitch, colt, act;
            if (tile < 8) { dst = convin; pitch = 2048; colt = 256 * tile; act = tile >= 6 ? 1 : 0; }
            else if (tile < 16) { dst = na; pitch = 2048; colt = 1024 + 256 * (tile - 12); act = tile >= 14 ? 1 : 0; }
            else if (tile < 22) { dst = g; pitch = 1536; colt = 512 + 256 * (tile - 18); act = tile >= 20 ? 1 : 0; }
            else { dst = gates; pitch = 3072; colt = 256 * (tile - TILE_GATE0); act = 2; }
            const bool cv = (tile == 12 || tile == 13) && u.pm < 16;
#pragma unroll
            for (int ai = 0; ai < 2; ++ai)
#pragma unroll
                for (int m = 0; m < 4; ++m) { const int r = rowb + 128 * ai + 16 * m; const float ri = G1_RINV(r);
#pragma unroll
                    for (int bj = 0; bj < 2; ++bj) { f32x4 v0 = acc[ai][bj][m][0] * ri + bv[bj][0], v1 = acc[ai][bj][m][1] * ri + bv[bj][1];
                        if (act == 1) {
#pragma unroll
                            for (int j = 0; j < 4; ++j) { v0[j] = fsilu(v0[j]); v1[j] = fsilu(v1[j]); } }
                        else if (act == 2) {
#pragma unroll
                            for (int j = 0; j < 4; ++j) { v0[j] = fsigmoid(v0[j]); v1[j] = fsigmoid(v1[j]); } }
                        const int c8 = 128 * bj + 32 * wc + 8 * fq;
                        u32x4 w; w.x = cvt_pk_bf16(v0[0], v0[1]); w.y = cvt_pk_bf16(v0[2], v0[3]); w.z = cvt_pk_bf16(v1[0], v1[1]); w.w = cvt_pk_bf16(v1[2], v1[3]);
                        *(u32x4*)(dst + (size_t)r * pitch + colt + c8) = w;
                        if (cv) { const int c = 256 * (tile - 12) + c8, head = c >> 6, d = c & 63;
                            float* o = out_cv + ((((size_t)u.pm * DEPTH + layer) * 8 + head) * 256 + (r & 255)) * 64 + d;
                            *(f32x4*)o = v0 * DBG_SCALE; *(f32x4*)(o + 4) = v1 * DBG_SCALE; } }
                    asm volatile("" ::: "memory"); }
        } else if (tile < 12) {
            const bool isk = tile >= 10; const float* nw = isk ? knw : qnw; const int head = 4 * (tile & 1) + wc;
            f32x4 w0[2], w1[2];
#pragma unroll
            for (int bj = 0; bj < 2; ++bj) { w0[bj] = *(const f32x4*)(nw + 32 * bj + 8 * fq); w1[bj] = *(const f32x4*)(nw + 32 * bj + 8 * fq + 4); }
#pragma unroll
            for (int ai = 0; ai < 2; ++ai)
#pragma unroll
                for (int m = 0; m < 4; ++m) { const int r = rowb + 128 * ai + 16 * m; const float ri = G1_RINV(r);
                    f32x4 v[2][2]; float ss = 0.f;
#pragma unroll
                    for (int bj = 0; bj < 2; ++bj)
#pragma unroll
                        for (int n = 0; n < 2; ++n) { v[bj][n] = acc[ai][bj][m][n] * ri + bv[bj][n]; ss += (v[bj][n][0] * v[bj][n][0] + v[bj][n][1] * v[bj][n][1]) + (v[bj][n][2] * v[bj][n][2] + v[bj][n][3] * v[bj][n][3]); }
                    ss += __shfl_xor(ss, 16); ss += __shfl_xor(ss, 32);
                    const float rn = __builtin_amdgcn_rsqf(ss * (1.0f / 64.0f) + EPS);
#pragma unroll
                    for (int bj = 0; bj < 2; ++bj) { const f32x4 a = v[bj][0] * rn * w0[bj], b = v[bj][1] * rn * w1[bj];
                        u32x4 w; w.x = cvt_pk_bf16(a[0], a[1]); w.y = cvt_pk_bf16(a[2], a[3]); w.z = cvt_pk_bf16(b[0], b[1]); w.w = cvt_pk_bf16(b[2], b[3]);
                        *(u32x4*)(na + (size_t)r * 2048 + (isk ? 512 : 0) + 64 * head + 32 * bj + 8 * fq) = w;
                        if (isk && u.pm < 16) { float* o = out_ck + ((((size_t)u.pm * DEPTH + layer) * 8 + head) * 256 + (r & 255)) * 64 + 32 * bj + 8 * fq;
                            *(f32x4*)o = a * DBG_SCALE; *(f32x4*)(o + 4) = b * DBG_SCALE; } }
                    asm volatile("" ::: "memory"); }
        } else if (tile < 18) {
            const bool isq = tile == 16; const bool lat = u.pm >= 16; const float qs = isq ? 0.125f : 1.0f;
            float inv[4];
#pragma unroll
            for (int j = 0; j < 4; ++j) inv[j] = __builtin_amdgcn_exp2f(-(float)(4 * fq + j) * 0.83048202372184059f) * 0.15915494309189535f;
#pragma unroll
            for (int ai = 0; ai < 2; ++ai)
#pragma unroll
                for (int m = 0; m < 4; ++m) { const int r = rowb + 128 * ai + 16 * m; const float ri = G1_RINV(r);
                    float prow = (float)(4 * ((u.pm - 16) & 7) + 2 * ai + wr), pcolf = (float)(16 * m + fr); asm volatile("" : "+v"(prow), "+v"(pcolf));
#pragma unroll
                    for (int bj = 0; bj < 2; ++bj) { f32x4 a = acc[ai][bj][m][0] * ri + bv[bj][0], b = acc[ai][bj][m][1] * ri + bv[bj][1];
                        if (lat) { const float pos = bj == 0 ? prow : pcolf;
#pragma unroll
                            for (int j = 0; j < 4; ++j) { const float t = pos * inv[j], sn = __builtin_amdgcn_sinf(t), cs = __builtin_amdgcn_cosf(t); const float x = a[j], y = b[j]; a[j] = x * cs - y * sn; b[j] = x * sn + y * cs; } }
                        a = a * qs; b = b * qs;
                        bf16_t* o = g + (size_t)r * 1536 + 256 * (tile - 16) + 64 * wc + 32 * bj + 4 * fq;
                        u32x2 wa, wb; wa.x = cvt_pk_bf16(a[0], a[1]); wa.y = cvt_pk_bf16(a[2], a[3]); wb.x = cvt_pk_bf16(b[0], b[1]); wb.y = cvt_pk_bf16(b[2], b[3]);
                        *(u32x2*)o = wa; *(u32x2*)(o + 16) = wb; }
                    asm volatile("" ::: "memory"); }
        } else {
            if (wc == 0) {
#pragma unroll
                for (int ai = 0; ai < 2; ++ai)
#pragma unroll
                    for (int m = 0; m < 4; ++m) { const int r = rowb + 128 * ai + 16 * m; const float ri = G1_RINV(r);
#pragma unroll
                        for (int n = 0; n < 2; ++n) *(f32x4*)(lr + (size_t)r * 32 + 16 * n + 4 * fq) = acc[ai][0][m][n] * ri + bv[0][n]; } }
        }
    }
};

struct EpiG2 {
    static constexpr bool PERM = false, AFTER_DRAIN = false, MID = true; static constexpr int MID_T0 = 8, MID_T1 = 16;
    const bf16_t* gates; bf16_t* merged;
    static __device__ __forceinline__ float cl(float x) { return __builtin_fmaxf(x, 1e-6f); }
    __device__ __forceinline__ void mid(f32x4 (&acc)[2][2][4][2], const Unit& u, int seg, int wr, int wc, int fr, int fq) const {
        int rowb = u.pm * BM + wr * 64 + fr; asm volatile("" : "+v"(rowb));
#pragma unroll
        for (int ai = 0; ai < 2; ++ai)
#pragma unroll
            for (int m = 0; m < 4; ++m) { const bf16_t* gp = gates + (size_t)(rowb + 128 * ai + 16 * m) * 3072 + seg * 1024 + u.pn * 256 + 32 * wc + 8 * fq;
#pragma unroll
                for (int bj = 0; bj < 2; ++bj) { const u32x4 ga = *(const u32x4*)(gp + 128 * bj), gb = *(const u32x4*)(gp + 1024 + 128 * bj);
                    f32x4 r0, r1;
                    r0[0] = cl(bflo(ga.x)) * __builtin_amdgcn_rcpf(cl(bflo(gb.x))); r0[1] = cl(bfhi(ga.x)) * __builtin_amdgcn_rcpf(cl(bfhi(gb.x)));
                    r0[2] = cl(bflo(ga.y)) * __builtin_amdgcn_rcpf(cl(bflo(gb.y))); r0[3] = cl(bfhi(ga.y)) * __builtin_amdgcn_rcpf(cl(bfhi(gb.y)));
                    r1[0] = cl(bflo(ga.z)) * __builtin_amdgcn_rcpf(cl(bflo(gb.z))); r1[1] = cl(bfhi(ga.z)) * __builtin_amdgcn_rcpf(cl(bfhi(gb.z)));
                    r1[2] = cl(bflo(ga.w)) * __builtin_amdgcn_rcpf(cl(bflo(gb.w))); r1[3] = cl(bfhi(ga.w)) * __builtin_amdgcn_rcpf(cl(bfhi(gb.w)));
                    acc[ai][bj][m][0] *= r0; acc[ai][bj][m][1] *= r1; }
                asm volatile("" ::: "memory"); }
    }
    __device__ __forceinline__ void operator()(const f32x4 (&acc)[2][2][4][2], const Unit& u, int wr, int wc, int fr, int fq) const {
        int rowb = u.pm * BM + wr * 64 + fr; asm volatile("" : "+v"(rowb));
#pragma unroll
        for (int ai = 0; ai < 2; ++ai)
#pragma unroll
            for (int m = 0; m < 4; ++m) { const size_t r = (size_t)(rowb + 128 * ai + 16 * m); const int c8 = u.pn * 256 + 32 * wc + 8 * fq;
#pragma unroll
                for (int bj = 0; bj < 2; ++bj) { const u32x4 gc = *(const u32x4*)(gates + r * 3072 + 2048 + c8 + 128 * bj);
                    const f32x4 a = acc[ai][bj][m][0], b = acc[ai][bj][m][1];
                    u32x4 w; w.x = cvt_pk_bf16(a[0] * cl(bflo(gc.x)), a[1] * cl(bfhi(gc.x))); w.y = cvt_pk_bf16(a[2] * cl(bflo(gc.y)), a[3] * cl(bfhi(gc.y)));
                    w.z = cvt_pk_bf16(b[0] * cl(bflo(gc.z)), b[1] * cl(bfhi(gc.z))); w.w = cvt_pk_bf16(b[2] * cl(bflo(gc.w)), b[3] * cl(bfhi(gc.w)));
                    *(u32x4*)(merged + r * 1024 + c8 + 128 * bj) = w; }
                asm volatile("" ::: "memory"); }
    }
};

struct EpiG3 {
    static constexpr bool PERM = false, AFTER_DRAIN = false, MID = false; static constexpr int MID_T0 = 0, MID_T1 = 0;
    const float* xin_ctx; const float* xin_lat;
    float* xout; const float* gatem; const float* weffn; bf16_t* ap; float* ssp;
    __device__ __forceinline__ void operator()(const f32x4 (&acc)[2][2][4][2], const Unit& u, int wr, int wc, int fr, int fq) const {
        const int bi = u.pm < 16 ? 0 : 1 + ((u.pm - 16) >> 3);
        int rowb = u.pm * BM + wr * 64 + fr; asm volatile("" : "+v"(rowb));
        const float* xin = u.pm < 16 ? xin_ctx : xin_lat - (size_t)M_CTX * DM;
        f32x4 gm[2][2], wn[2][2];
#pragma unroll
        for (int bj = 0; bj < 2; ++bj)
#pragma unroll
            for (int n = 0; n < 2; ++n) { const int c = u.pn * 256 + 128 * bj + 32 * wc + 16 * n + 4 * fq; gm[bj][n] = *(const f32x4*)(gatem + bi * DM + c);
                wn[bj][n] = weffn ? *(const f32x4*)(weffn + bi * DM + c) : (f32x4){0.f, 0.f, 0.f, 0.f}; }
#pragma unroll
        for (int ai = 0; ai < 2; ++ai)
#pragma unroll
            for (int m = 0; m < 4; ++m) { const size_t r = (size_t)(rowb + 128 * ai + 16 * m); float ssq = 0.f;
#pragma unroll
                for (int bj = 0; bj < 2; ++bj)
#pragma unroll
                    for (int n = 0; n < 2; ++n) { const int c = u.pn * 256 + 128 * bj + 32 * wc + 16 * n + 4 * fq;
                        const f32x4 x = *(const f32x4*)(xin + r * DM + c); const f32x4 xn = x + gm[bj][n] * acc[ai][bj][m][n];
                        *(f32x4*)(xout + r * DM + c) = xn;
                        if (weffn) { ssq += (xn[0] * xn[0] + xn[1] * xn[1]) + (xn[2] * xn[2] + xn[3] * xn[3]); const f32x4 a = xn * wn[bj][n];
                            u32x2 w; w.x = cvt_pk_bf16(a[0], a[1]); w.y = cvt_pk_bf16(a[2], a[3]); *(u32x2*)(ap + r * DM + c) = w; } }
                if (weffn) { ssq += __shfl_xor(ssq, 16); ssq += __shfl_xor(ssq, 32); if (fq == 0) ssp[r * 16 + 4 * u.pn + wc] = ssq; }
                asm volatile("" ::: "memory"); }
    }
};

template <class Epi, class Sched, bool ALIGN_EPI = false, bool SP2 = false>
__device__ __forceinline__ void gemm_phase(PG8_LAS unsigned char* lds, const Gemm g, const Sched& S, const Epi& E) {
    int tid = threadIdx.x; asm volatile("" : "+v"(tid));
    const int wid = __builtin_amdgcn_readfirstlane(tid >> 6), lane = tid & 63, wr = wid >> 2, wc = wid & 3, fr = lane & 15, fq = lane >> 4;
    const int K = g.K, nt = K / BK;
    unsigned voffA[2], voffB[2];
#pragma unroll
    for (int i = 0; i < 2; ++i) { int R, C; stage_rc(tid * 16 + i * 8192, R, C); const int Rb = Epi::PERM ? ((R & ~31) + perm32(R & 31)) : R;
        voffA[i] = (unsigned)(R * K + C) * 2u; voffB[i] = (unsigned)(Rb * K + C) * 2u; }
    const size_t kstep = (size_t)(BK * 2);
    const size_t hstep = (size_t)HALF * K * 2;
    const size_t tstep = 2 * hstep;
    const unsigned ldsw = (unsigned)wid * 1024u;
    const int aoff = lds_byte(wr * 64 + fr, fq * 8), boff = lds_byte(wc * 32 + fr, fq * 8);
#define PG8_SA(b, h) (((b) * 2 + (h)) * HTB)
#define PG8_SB(b, h) ((4 + (b) * 2 + (h)) * HTB)
#define PG8_STAGE(bufoff, gbase, voff) do { _Pragma("unroll") for (int _i = 0; _i < 2; ++_i) \
        __builtin_amdgcn_global_load_lds((const unsigned*)((const char*)(gbase) + (voff)[_i]), (PG8_LAS unsigned*)(lds + (bufoff) + ldsw + _i * 8192), 16, 0, 0); } while (0)
#define PG8_LDA(dst, b, h) do { _Pragma("unroll") for (int m = 0; m < 4; ++m) _Pragma("unroll") for (int k = 0; k < 2; ++k) dst[m][k] = *(const PG8_LAS bf16x8*)(lds + PG8_SA(b, h) + aoff + m * 2048 + k * 1024); } while (0)
#define PG8_LDB(dst, b, h) do { _Pragma("unroll") for (int n = 0; n < 2; ++n) _Pragma("unroll") for (int k = 0; k < 2; ++k) dst[n][k] = *(const PG8_LAS bf16x8*)(lds + PG8_SB(b, h) + boff + n * 2048 + k * 1024); } while (0)
#define PG8_MMA(ai, bj, At, Bt) do { __builtin_amdgcn_s_setprio(1); _Pragma("unroll") for (int m = 0; m < 4; ++m) _Pragma("unroll") for (int n = 0; n < 2; ++n) _Pragma("unroll") for (int k = 0; k < 2; ++k) \
        acc[ai][bj][m][n] = __builtin_amdgcn_mfma_f32_16x16x32_bf16(Bt[n][k], At[m][k], acc[ai][bj][m][n], 0, 0, 0); __builtin_amdgcn_s_setprio(0); } while (0)
#define PG8_WAIT_V(n) asm volatile("s_waitcnt vmcnt(" #n ")" ::: "memory")
#define PG8_WAIT_L(n) asm volatile("s_waitcnt lgkmcnt(" #n ")" ::: "memory")
#define PG8_BAR __builtin_amdgcn_s_barrier()
#define PG8_SCHED __builtin_amdgcn_sched_barrier(0)
    Unit cur, nxt; int ui = 0;
    if (!S.next(0, cur)) return;
    f32x4 acc[2][2][4][2];
#pragma unroll
    for (int a = 0; a < 2; ++a)
#pragma unroll
        for (int b = 0; b < 2; ++b)
#pragma unroll
            for (int m = 0; m < 4; ++m)
#pragma unroll
                for (int n = 0; n < 2; ++n) acc[a][b][m][n] = (f32x4){0.f, 0.f, 0.f, 0.f};
    bf16x8 At[4][2], B0[2][2], B1[2][2];
    const char* cA = (const char*)g.A + (size_t)cur.pm * tstep; const char* cB = (const char*)g.Bt + (size_t)cur.pn * tstep;
    S.a_ready(cur);
    if constexpr (SP2) {
        PG8_STAGE(PG8_SB(0, 0), cB, voffB); PG8_STAGE(PG8_SB(0, 1), cB + hstep, voffB); PG8_STAGE(PG8_SA(0, 0), cA, voffA); PG8_STAGE(PG8_SA(0, 1), cA + hstep, voffA);
        if (wr == 1) PG8_BAR;
        PG8_WAIT_V(2); PG8_BAR;
        PG8_STAGE(PG8_SB(1, 0), cB + kstep, voffB); PG8_STAGE(PG8_SA(1, 0), cA + kstep, voffA); PG8_STAGE(PG8_SB(1, 1), cB + hstep + kstep, voffB);
        PG8_WAIT_V(6); PG8_BAR;
    } else {
        PG8_STAGE(PG8_SB(0, 0), cB, voffB); PG8_STAGE(PG8_SA(0, 0), cA, voffA); PG8_STAGE(PG8_SB(0, 1), cB + hstep, voffB); PG8_STAGE(PG8_SA(0, 1), cA + hstep, voffA);
        if (wr == 1) PG8_BAR;
        PG8_WAIT_V(4); PG8_BAR;
        PG8_STAGE(PG8_SB(1, 0), cB + kstep, voffB); PG8_STAGE(PG8_SA(1, 0), cA + kstep, voffA); PG8_STAGE(PG8_SB(1, 1), cB + hstep + kstep, voffB);
        PG8_WAIT_V(6); PG8_BAR;
    }
    for (;;) {
        const bool has_next = S.next(ui + 1, nxt);
        const char* nA = has_next ? (const char*)g.A + (size_t)nxt.pm * tstep : cA; const char* nB = has_next ? (const char*)g.Bt + (size_t)nxt.pn * tstep : cB;
        for (int t = 0; t < nt; t += 2) {
            const bool last = (t == nt - 2);
            const char* a1 = cA + (size_t)(t + 1) * kstep;
            const char* a2 = last ? nA : cA + (size_t)(t + 2) * kstep; const char* b2 = last ? nB : cB + (size_t)(t + 2) * kstep;
            const char* a3 = a2 + kstep; const char* b3 = b2 + kstep;
            if (last && has_next) S.a_ready(nxt);
            if constexpr (SP2) {
            PG8_LDB(B0, 0, 0); PG8_LDB(B1, 0, 1); PG8_SCHED; PG8_LDA(At, 0, 0); PG8_STAGE(PG8_SA(1, 1), a1 + hstep, voffA);
            PG8_WAIT_V(8); PG8_WAIT_L(0); PG8_BAR; PG8_MMA(0, 0, At, B0); PG8_MMA(0, 1, At, B1); PG8_BAR; PG8_SCHED;
            PG8_LDA(At, 0, 1); PG8_STAGE(PG8_SB(0, 0), b2, voffB); PG8_STAGE(PG8_SB(0, 1), b2 + hstep, voffB); PG8_STAGE(PG8_SA(0, 0), a2, voffA);
            PG8_WAIT_V(8); PG8_WAIT_L(0); PG8_BAR; PG8_MMA(1, 0, At, B0); PG8_MMA(1, 1, At, B1); PG8_BAR; PG8_SCHED;
            PG8_LDB(B0, 1, 0); PG8_LDB(B1, 1, 1); PG8_SCHED; PG8_LDA(At, 1, 0); PG8_STAGE(PG8_SA(0, 1), a2 + hstep, voffA);
            PG8_WAIT_V(8); PG8_WAIT_L(0); PG8_BAR; PG8_MMA(0, 0, At, B0); PG8_MMA(0, 1, At, B1); PG8_BAR; PG8_SCHED;
            PG8_LDA(At, 1, 1); PG8_STAGE(PG8_SB(1, 0), b3, voffB); PG8_STAGE(PG8_SB(1, 1), b3 + hstep, voffB); PG8_STAGE(PG8_SA(1, 0), a3, voffA);
            PG8_WAIT_V(8); PG8_WAIT_L(0); PG8_BAR; PG8_MMA(1, 0, At, B0); PG8_MMA(1, 1, At, B1); PG8_BAR; PG8_SCHED;
            } else {
            PG8_LDB(B0, 0, 0); PG8_SCHED; PG8_LDA(At, 0, 0); PG8_STAGE(PG8_SA(1, 1), a1 + hstep, voffA);
            PG8_WAIT_L(8); PG8_BAR; PG8_WAIT_L(0); PG8_MMA(0, 0, At, B0); PG8_BAR; PG8_SCHED;
            PG8_LDB(B1, 0, 1); PG8_STAGE(PG8_SB(0, 0), b2, voffB);
            PG8_BAR; PG8_WAIT_L(0); PG8_MMA(0, 1, At, B1); PG8_BAR;
            PG8_LDA(At, 0, 1); PG8_STAGE(PG8_SA(0, 0), a2, voffA);
            PG8_BAR; PG8_WAIT_L(0); PG8_MMA(1, 0, At, B0); PG8_BAR; PG8_SCHED;
            PG8_STAGE(PG8_SB(0, 1), b2 + hstep, voffB);
            PG8_WAIT_V(6); PG8_BAR; PG8_MMA(1, 1, At, B1); PG8_BAR;
            PG8_LDB(B0, 1, 0); PG8_SCHED; PG8_LDA(At, 1, 0); PG8_STAGE(PG8_SA(0, 1), a2 + hstep, voffA);
            PG8_WAIT_L(8); PG8_BAR; PG8_WAIT_L(0); PG8_MMA(0, 0, At, B0); PG8_BAR; PG8_SCHED;
            PG8_LDB(B1, 1, 1); PG8_STAGE(PG8_SB(1, 0), b3, voffB);
            PG8_BAR; PG8_WAIT_L(0); PG8_MMA(0, 1, At, B1); PG8_BAR;
            PG8_LDA(At, 1, 1); PG8_STAGE(PG8_SA(1, 0), a3, voffA);
            PG8_BAR; PG8_WAIT_L(0); PG8_MMA(1, 0, At, B0); PG8_BAR; PG8_SCHED;
            PG8_STAGE(PG8_SB(1, 1), b3 + hstep, voffB);
            PG8_WAIT_V(6); PG8_BAR; PG8_MMA(1, 1, At, B1); PG8_BAR;
            }
            if constexpr (Epi::MID) { if (t + 2 == Epi::MID_T0 || t + 2 == Epi::MID_T1) E.mid(acc, cur, (t + 2 == Epi::MID_T0) ? 0 : 1, wr, wc, fr, fq); }
        }
        if constexpr (ALIGN_EPI) { if (wr == 0) PG8_BAR; }
        if constexpr (!Epi::AFTER_DRAIN) { E(acc, cur, wr, wc, fr, fq); S.done(cur); }
        if (!has_next) break;
#pragma unroll
        for (int a = 0; a < 2; ++a)
#pragma unroll
            for (int b = 0; b < 2; ++b)
#pragma unroll
                for (int m = 0; m < 4; ++m)
#pragma unroll
                    for (int n = 0; n < 2; ++n) acc[a][b][m][n] = (f32x4){0.f, 0.f, 0.f, 0.f};
        cur = nxt; cA = nA; cB = nB; ++ui;
        if constexpr (ALIGN_EPI) { if (wr == 1) PG8_BAR; }
    }
    PG8_WAIT_V(0);
    if constexpr (!ALIGN_EPI) { if (wr == 0) PG8_BAR; }
    PG8_BAR;
    if constexpr (Epi::AFTER_DRAIN) { E.fused(acc, cur, wr, wc, fr, fq, lds, wid, lane); S.done(cur); }
#undef PG8_SA
#undef PG8_SB
#undef PG8_STAGE
#undef PG8_LDA
#undef PG8_LDB
#undef PG8_MMA
#undef PG8_WAIT_V
#undef PG8_WAIT_L
#undef PG8_BAR
#undef PG8_SCHED
}
}

#define XB_TMO      128
#define XB_XCNT(j)  (256  + 64 * (j))
#define XB_XSUB(j)  (1280 + 64 * (j))
#define XB_XGEN(j)  (2304 + 64 * (j))
#define XB_TOP      3328
#define XB_TOPGEN   3392
#define XCD_BAR_WORDS 3456
#define XB_SPIN_CAP (1u << 18)
__device__ __forceinline__ unsigned xb_ld(unsigned* p)              { return __hip_atomic_load(p, __ATOMIC_RELAXED, __HIP_MEMORY_SCOPE_AGENT); }
__device__ __forceinline__ unsigned xb_add(unsigned* p, unsigned v) { return __hip_atomic_fetch_add(p, v, __ATOMIC_RELAXED, __HIP_MEMORY_SCOPE_AGENT); }
__device__ __forceinline__ unsigned xb_xcc_id() { return (unsigned)__builtin_amdgcn_s_getreg((3 << 11) | 20) & 0xFu; }
#define XB_SPIN(cond, bar) do { unsigned _sp = 0; while (cond) { __builtin_amdgcn_s_sleep(1); \
    if ((++_sp & 255u) == 0u) { if (xb_ld(&(bar)[XB_TMO])) break; if (_sp > XB_SPIN_CAP) { atomicAdd(&(bar)[XB_TMO], 1u); break; } } } } while (0)
struct XcdBarrier { unsigned* bar; unsigned x; volatile LAS unsigned* st; };
__device__ __forceinline__ XcdBarrier xcd_barrier_post(unsigned* bar, volatile LAS unsigned* st) {
    XcdBarrier b; b.bar = bar; b.x = xb_xcc_id(); b.st = st;
    if (threadIdx.x == 0) (void)xb_add(&bar[XB_XCNT(b.x)], 1u);
    return b;
}
__device__ __forceinline__ void xcd_barrier_complete(unsigned* bar, unsigned x, unsigned& nloc, unsigned& nx) {
    const unsigned G = gridDim.x * gridDim.y * gridDim.z;
    unsigned sum, cnt, mine, sp = 0u;
    for (;;) {
        sum = 0u; cnt = 0u; mine = 0u;
#pragma unroll
        for (unsigned j = 0; j < 16; ++j) { const unsigned c = xb_ld(&bar[XB_XCNT(j)]); sum += c; cnt += (c > 0u) ? 1u : 0u; mine = (j == x) ? c : mine; }
        if (sum == G) break;
        __builtin_amdgcn_s_sleep(1);
        if ((++sp & 255u) == 0u) { if (xb_ld(&bar[XB_TMO])) break; if (sp > XB_SPIN_CAP) { atomicAdd(&bar[XB_TMO], 1u); break; } }
    }
    nloc = mine > 0u ? mine : 1u; nx = cnt > 0u ? cnt : 1u;
}
__device__ __forceinline__ void xcd_barrier(const XcdBarrier& b) {
    asm volatile("s_waitcnt vmcnt(0)" ::: "memory");
    __syncthreads();
    if (threadIdx.x == 0) {
        unsigned* bar = b.bar;
        __builtin_amdgcn_s_waitcnt(0);
        unsigned nloc = b.st[0], nx = b.st[1];
        if (nloc == 0u) { xcd_barrier_complete(bar, b.x, nloc, nx); b.st[0] = nloc; b.st[1] = nx; }
        const unsigned old = xb_add(&bar[XB_XSUB(b.x)], 1u);
        const unsigned gen = old / nloc;
        if (old + 1u == (gen + 1u) * nloc) {
            __builtin_amdgcn_fence(__ATOMIC_RELEASE, "agent");
            asm volatile("s_waitcnt vmcnt(0)" ::: "memory");
            const unsigned og = xb_add(&bar[XB_TOP], 1u);
            const unsigned tg = og / nx;
            if (og + 1u == (tg + 1u) * nx) xb_add(&bar[XB_TOPGEN], 1u);
            else XB_SPIN(xb_ld(&bar[XB_TOPGEN]) == tg, bar);
            __builtin_amdgcn_fence(__ATOMIC_ACQUIRE, "agent");
            xb_add(&bar[XB_XGEN(b.x)], 1u);
            asm volatile("s_waitcnt vmcnt(0)" ::: "memory");
        } else {
            XB_SPIN(xb_ld(&bar[XB_XGEN(b.x)]) == gen, bar);
            __builtin_amdgcn_fence(__ATOMIC_ACQUIRE, "agent");
            asm volatile("s_waitcnt vmcnt(0)" ::: "memory");
        }
    }
    __syncthreads();
}

struct P {
    const float *x_prompt, *x_sample, *c, *cache_k, *cache_v, *state_fwd, *state_bwd, *c_ctx, *norm_w, *w_ada, *b_ada, *w_in, *conv_w, *q_norm_w, *k_norm_w, *rpb,
                *w_alpha, *b_alpha, *gla_norm_w, *w_branch, *w_gate, *b_gate, *w_out;
    float* out; unsigned char* ws;
};
__device__ __forceinline__ float wave_sum(float v) {
#pragma unroll
    for (int o = 1; o < 64; o <<= 1) v += __shfl_xor(v, o);
    return v;
}

__device__ __forceinline__ void cvt_item(const float* W, int Nsrc, int k0, int srccol, bf16* dst, int Kdst, LAS float* scr, int lane) {
#pragma unroll 8
    for (int i = 0; i < 32; ++i) { const int kk = 2 * i + (lane >> 5); scr[kk * 33 + (lane & 31)] = srccol >= 0 ? W[(size_t)(k0 + kk) * Nsrc + srccol] : 0.f; }
    LDS_WAIT(); asm volatile("" ::: "memory");
    const int c = lane & 7;
#pragma unroll
    for (int j = 0; j < 4; ++j) { const int n = (lane >> 3) + 8 * j; const LAS float* s = scr + (8 * c) * 33 + n;
        v4u o; o.x = pk2(s[0 * 33], s[1 * 33]); o.y = pk2(s[2 * 33], s[3 * 33]); o.z = pk2(s[4 * 33], s[5 * 33]); o.w = pk2(s[6 * 33], s[7 * 33]);
        *(GAS v4u*)(dst + (size_t)n * Kdst + 8 * c) = o; }
    LDS_WAIT(); asm volatile("" ::: "memory");
}
constexpr int CV1 = 16 * (N1 / 32), CV2 = 3 * 8 * 32, CV3 = 16 * 32, CVL = CV1 + CV2 + CV3;
__device__ __forceinline__ void p0a(const P& p, LAS unsigned char* lds, int tid, int lane, int wave) {
    bf16* WB1 = (bf16*)(p.ws + WS_WB1); bf16* WB2 = (bf16*)(p.ws + WS_WB2); bf16* WB3 = (bf16*)(p.ws + WS_WB3);
    LAS float* scr = (LAS float*)(lds + wave * 8448);
    LAS float* SC = (LAS float*)(lds + 69632);
    for (int idx = tid; idx < NMOD * DM; idx += 512) { const int i = idx >> 10, k = idx & 1023; const float v = i == 0 ? p.c_ctx[k] : p.c[(i - 1) * DM + k]; SC[idx] = fsilu(v); }
    __syncthreads();
    const int gw = blockIdx.x * 8 + wave, NGW = gridDim.x * 8;
    for (int it = gw; it < DEPTH * 8 * 48; it += NGW) { const int nc = it % 48, ks = (it / 48) & 7, l = it / 384;
        float a[NMOD];
#pragma unroll
        for (int i = 0; i < NMOD; ++i) a[i] = 0.f;
        const float* W = p.w_ada + ((size_t)l * DM + 128 * ks) * 3072 + 64 * nc + lane;
#pragma unroll 4
        for (int k = 0; k < 128; ++k) { const float w = W[(size_t)k * 3072];
#pragma unroll
            for (int i = 0; i < NMOD; ++i) a[i] += w * SC[i * DM + 128 * ks + k]; }
        float* o = (float*)(p.ws + WS_MODP) + ((size_t)(l * 8 + ks) * NMOD) * 3072 + 64 * nc + lane;
#pragma unroll
        for (int i = 0; i < NMOD; ++i) o[(size_t)i * 3072] = a[i]; }
    for (int it = gw; it < DEPTH * CVL; it += NGW) { const int l = it / CVL; int r = it % CVL;
        if (r < CV1) { const int kb = r / (N1 / 32), nb = r % (N1 / 32); int mat, col; wb1_src(32 * nb + (lane & 31), mat, col);
            const int umat = __builtin_amdgcn_readfirstlane(mat);
            const float* W = umat == 1 ? p.w_gate + (size_t)l * DM * 3072 : p.w_in + (size_t)l * DM * 5664;
            cvt_item(W, umat == 1 ? 3072 : 5664, 64 * kb, umat < 0 ? -1 : col, WB1 + ((size_t)l * N1 + 32 * nb) * DM + 64 * kb, DM, scr, lane); continue; }
        r -= CV1;
        if (r < CV2) { const int b = r >> 8, kb = (r >> 5) & 7, nb = r & 31; const int n = 32 * nb + (lane & 31);
            cvt_item(p.w_branch + ((size_t)(l * 3 + b) * 512) * DM, DM, 64 * kb, 256 * (n >> 8) + pcol_of_slot(n & 255), WB2 + ((size_t)l * DM + 32 * nb) * 1536 + 512 * b + 64 * kb, 1536, scr, lane); continue; }
        r -= CV2;
        { const int kb = r >> 5, nb = r & 31;
            cvt_item(p.w_out + (size_t)l * DM * DM, DM, 64 * kb, 32 * nb + (lane & 31), WB3 + ((size_t)l * DM + 32 * nb) * DM + 64 * kb, DM, scr, lane); } }
    { const size_t n8 = (size_t)NB_LAT * DEPTH * 8 * PAST * 64 / 8; const size_t gt = (size_t)blockIdx.x * 512 + tid, NT = (size_t)gridDim.x * 512;
        for (size_t i = gt; i < 2 * n8; i += NT) { const bool isv = i >= n8; const size_t j = isv ? i - n8 : i;
            const float* src = (isv ? p.cache_v : p.cache_k) + j * 8; const f32x4 a = *(const f32x4*)src, b = *(const f32x4*)(src + 4);
            v4u o; o.x = pk2(a[0], a[1]); o.y = pk2(a[2], a[3]); o.z = pk2(b[0], b[1]); o.w = pk2(b[2], b[3]);
            *(v4u*)((bf16*)(p.ws + (isv ? WS_CVB : WS_CKB)) + j * 8) = o; } }
}
__device__ __forceinline__ float mod_sum(const P& p, int l, int i, int n) {
    const float* mp = (const float*)(p.ws + WS_MODP) + ((size_t)(l * 8) * NMOD + i) * 3072 + n; float s = p.b_ada[l * 3072 + n];
#pragma unroll
    for (int ks = 0; ks < 8; ++ks) s += mp[(size_t)ks * NMOD * 3072];
    return s;
}
__device__ __forceinline__ void p0b(const P& p, LAS unsigned char* lds, int tid, int lane, int wave) {
    LAS float* SH = (LAS float*)lds;
    LAS float* WE = (LAS float*)(lds + 36864);
    const int lb = blockIdx.x & 3;
    for (int idx = tid; idx < NMOD * DM; idx += 512) { const int i = idx >> 10, k = idx & 1023;
        SH[idx] = mod_sum(p, lb, i, k); WE[idx] = p.norm_w[k] * (1.f + mod_sum(p, 0, i, DM + k)); }
    { float* WEFF = (float*)(p.ws + WS_WEFF); float* GATEM = (float*)(p.ws + WS_GATEM);
        const int gt = blockIdx.x * 512 + tid;
        if (gt < DEPTH * NMOD * DM) { const int l = gt / (NMOD * DM), i = (gt / DM) % NMOD, k = gt & 1023;
            WEFF[gt] = p.norm_w[l * DM + k] * (1.f + mod_sum(p, l, i, DM + k)); GATEM[gt] = mod_sum(p, l, i, 2 * DM + k); } }
    __syncthreads();
    { const bf16* WB1 = (const bf16*)(p.ws + WS_WB1) + (size_t)lb * N1 * DM; float* BV = (float*)(p.ws + WS_BIASV) + (size_t)lb * NMOD * N1;
        for (int n = (blockIdx.x >> 2) * 8 + wave; n < N1; n += (gridDim.x >> 2) * 8) {
            const v4u w0 = *(const v4u*)(WB1 + (size_t)n * DM + 8 * lane), w1 = *(const v4u*)(WB1 + (size_t)n * DM + 512 + 8 * lane);
            float wf[16] = {bflo(w0.x), bfhi(w0.x), bflo(w0.y), bfhi(w0.y), bflo(w0.z), bfhi(w0.z), bflo(w0.w), bfhi(w0.w), bflo(w1.x), bfhi(w1.x), bflo(w1.y), bfhi(w1.y), bflo(w1.z), bfhi(w1.z), bflo(w1.w), bfhi(w1.w)};
            int mat, col; wb1_src(n, mat, col);
#pragma unroll
            for (int i = 0; i < NMOD; ++i) { const LAS float* sh = SH + i * DM + 8 * lane; float a = 0.f;
#pragma unroll
                for (int e = 0; e < 8; ++e) a += wf[e] * sh[e] + wf[8 + e] * sh[512 + e];
                a = wave_sum(a);
                if (lane == 0) BV[(size_t)i * N1 + n] = a + (mat == 1 ? p.b_gate[lb * 3072 + col] : 0.f); } } }
    { bf16* AP = (bf16*)(p.ws + WS_AP); float* SSP = (float*)(p.ws + WS_SSP);
        for (int R = blockIdx.x * 8 + wave; R < MROWS; R += gridDim.x * 8) {
            const float* xr = R < M_CTX ? p.x_prompt + (size_t)R * DM : p.x_sample + (size_t)(R - M_CTX) * DM; const int bi = R < M_CTX ? 0 : 1 + (R - M_CTX) / T_LAT;
            f32x4 v[4]; float ss = 0.f;
#pragma unroll
            for (int j = 0; j < 4; ++j) { v[j] = *(const f32x4*)(xr + 4 * lane + 256 * j); ss += (v[j][0] * v[j][0] + v[j][1] * v[j][1]) + (v[j][2] * v[j][2] + v[j][3] * v[j][3]); }
            ss = wave_sum(ss);
#pragma unroll
            for (int j = 0; j < 4; ++j) { const f32x4 w = *(const LAS f32x4*)(WE + bi * DM + 4 * lane + 256 * j); const f32x4 a = v[j] * w;
                v2u o; o.x = pk2(a[0], a[1]); o.y = pk2(a[2], a[3]); *(v2u*)(AP + (size_t)R * DM + 4 * lane + 256 * j) = o; }
            if (lane < 16) SSP[(size_t)R * 16 + lane] = lane == 0 ? ss : 0.f; } }
}

__device__ __forceinline__ int crow(int r, int hi) { return (r & 3) + 8 * (r >> 2) + 4 * hi; }
__device__ __forceinline__ f32x16 mfma32(bf16x8 a, bf16x8 b, f32x16 c) { return __builtin_amdgcn_mfma_f32_32x32x16_bf16(a, b, c, 0, 0, 0); }
typedef short v4i16_t __attribute__((ext_vector_type(4)));
__device__ __forceinline__ s16x4 ldtr(const LAS unsigned char* p) { return __builtin_bit_cast(s16x4, __builtin_amdgcn_ds_read_tr16_b64_v4i16((LAS v4i16_t*)p)); }
__device__ __forceinline__ bf16x8 cat8(s16x4 lo, s16x4 hi) { return (bf16x8){lo[0], lo[1], lo[2], lo[3], hi[0], hi[1], hi[2], hi[3]}; }
__device__ __forceinline__ unsigned cvtpk(float lo, float hi) { unsigned r; asm volatile("v_cvt_pk_bf16_f32 %0, %1, %2" : "=v"(r) : "v"(lo), "v"(hi)); return r; }
__device__ __forceinline__ bf16x8 accfrag(const f32x16& x, int s) {
    v4u w; const int b = 8 * s;
    w.x = cvtpk(x[b + 0], x[b + 1]); w.y = cvtpk(x[b + 2], x[b + 3]); w.z = cvtpk(x[b + 4], x[b + 5]); w.w = cvtpk(x[b + 6], x[b + 7]);
    return __builtin_bit_cast(bf16x8, w);
}

__device__ __forceinline__ void conv_unit(const P& p, int layer, int unit, int tid) {
    const bf16* CI = (const bf16*)(p.ws + WS_CONVIN); bf16* Y = (bf16*)(p.ws + WS_Y);
    const int cl = tid & 63, tg = tid >> 6, c0 = 8 * cl;
    const int row0 = unit * 64 + 8 * tg;
    const int T = row0 < M_CTX ? T_CTX : T_LAT; const int tin = (row0 < M_CTX ? row0 : row0 - M_CTX) % T;
    float w[3][8];
#pragma unroll
    for (int k = 0; k < 3; ++k) { const f32x4 a = *(const f32x4*)(p.conv_w + ((size_t)layer * 3 + k) * 512 + c0), b = *(const f32x4*)(p.conv_w + ((size_t)layer * 3 + k) * 512 + c0 + 4);
#pragma unroll
        for (int e = 0; e < 4; ++e) { w[k][e] = a[e]; w[k][4 + e] = b[e]; } }
    float up[8], uc[8], un[8];
    auto LD8 = [](const bf16* q, float (&o)[8]) { const v4u v = *(const v4u*)q; o[0] = bflo(v.x); o[1] = bfhi(v.x); o[2] = bflo(v.y); o[3] = bfhi(v.y); o[4] = bflo(v.z); o[5] = bfhi(v.z); o[6] = bflo(v.w); o[7] = bfhi(v.w); };
    auto U = [&](int row, bool valid, float (&o)[8]) { if (valid) { float xa[8], ca[8]; LD8(CI + (size_t)row * 2048 + c0, xa); LD8(CI + (size_t)row * 2048 + 1024 + c0, ca);
#pragma unroll
            for (int e = 0; e < 8; ++e) o[e] = xa[e] * ca[e]; } else {
#pragma unroll
            for (int e = 0; e < 8; ++e) o[e] = 0.f; } };
    U(row0 - 1, tin > 0, up); U(row0, true, uc);
#pragma unroll
    for (int i = 0; i < 8; ++i) { const int row = row0 + i; U(row + 1, tin + i + 1 < T, un);
        float ba[8], sg[8]; LD8(CI + (size_t)row * 2048 + 512 + c0, ba); LD8(CI + (size_t)row * 2048 + 1536 + c0, sg);
        float y[8];
#pragma unroll
        for (int e = 0; e < 8; ++e) y[e] = ba[e] * (w[0][e] * up[e] + w[1][e] * uc[e] + w[2][e] * un[e]) * sg[e];
        v4u o; o.x = pk2(y[0], y[1]); o.y = pk2(y[2], y[3]); o.z = pk2(y[4], y[5]); o.w = pk2(y[6], y[7]);
        *(v4u*)(Y + (size_t)row * 1536 + c0) = o;
#pragma unroll
        for (int e = 0; e < 8; ++e) { up[e] = uc[e]; uc[e] = un[e]; } }
}

constexpr int NA_K = 0, NA_V = 16384, NA_TAB = 32768;
__device__ __forceinline__ int na_koff(int key, int chunk) { return key * 128 + ((chunk ^ ((key >> 1) & 7)) << 4); }
__device__ __forceinline__ int na_voff(int key, int chunk) { return key * 128 + ((chunk ^ (((key >> 1) & 1) << 2)) << 4); }
template <bool LAT>
__device__ __forceinline__ void na_unit(const P& p, LAS unsigned char* lds, int layer, int b, int h, int R4, int tid, int lane, int wave) {
    const bf16* NA = (const bf16*)(p.ws + WS_NA); bf16* Y = (bf16*)(p.ws + WS_Y);
    const int r32 = lane & 31, hh = lane >> 5;
    int grow = 0, chalf = 0, qrow;
    if (LAT) { grow = 4 * R4 + (wave >> 1); chalf = wave & 1; qrow = M_CTX + b * T_LAT + 64 * grow + 32 * chalf + r32; } else qrow = b * T_CTX + 32 * wave + r32;
    bf16x8 qf[4];
#pragma unroll
    for (int kk = 0; kk < 4; ++kk) qf[kk] = *(const bf16x8*)(NA + (size_t)qrow * 2048 + 64 * h + 16 * kk + 8 * hh);
    int ntile = 4, nwin = 0, kr0 = 0, myrs = 0;
    if (LAT) { const int lo = min(max(4 * R4 - 4, 0), 24), hi = min(max(4 * R4 + 3 - 4, 0), 24); kr0 = lo; nwin = hi + 8 - lo; ntile = nwin + 8; myrs = min(max(grow - 4, 0), 24); }
    LAS float* tab = (LAS float*)(lds + NA_TAB);
    if (LAT) { for (int i = tid; i < 15 * 32; i += 512) { const int dr = i >> 5, dc = i & 31; tab[i] = dc < 31 ? p.rpb[(((size_t)layer * 8 + h) * 15 + dr) * 31 + dc] * LOG2E : 0.f; } }
    const int skey = tid >> 3, sch = tid & 7;
    const bf16* CKB = (const bf16*)(p.ws + WS_CKB); const bf16* CVB = (const bf16*)(p.ws + WS_CVB);
#define NA_SRC(i, kp, vp) do { if (!LAT) { const size_t row = (size_t)(b * T_CTX + 64 * (i) + skey); kp = NA + row * 2048 + 512 + 64 * h + 8 * sch; vp = kp + 512; } \
        else if ((i) < nwin) { const size_t row = (size_t)(M_CTX + b * T_LAT + 64 * (kr0 + (i)) + skey); kp = NA + row * 2048 + 512 + 64 * h + 8 * sch; vp = kp + 512; } \
        else { const size_t idx = ((((size_t)b * DEPTH + layer) * 8 + h) * PAST + 64 * ((i) - nwin) + skey) * 64 + 8 * sch; kp = CKB + idx; vp = CVB + idx; } } while (0)
    v4u kreg, vreg;
    { const bf16 *kp, *vp; NA_SRC(0, kp, vp); kreg = *(const v4u*)kp; vreg = *(const v4u*)vp; }
    *(LAS v4u*)(lds + NA_K + na_koff(skey, sch)) = kreg; *(LAS v4u*)(lds + NA_V + na_voff(skey, sch)) = vreg;
    __syncthreads();
    const float C = 0.125f * LOG2E;
    const int qc = 32 * chalf + r32, cs = min(max(qc - 8, 0), 48);
    float m_run = -1e30f, l_run = 0.f; f32x16 o0 = {0}, o1 = {0};
    const int tq = (lane & 15) >> 2, tp = lane & 3, tg = (lane >> 4) & 1;
#pragma nounroll
    for (int i = 0; i < ntile; ++i) {
        const int buf = i & 1;
        if (i + 1 < ntile) { const bf16 *kp, *vp; NA_SRC(i + 1, kp, vp); kreg = *(const v4u*)kp; vreg = *(const v4u*)vp; }
        bool active = true; int dr = 0;
        if (LAT && i < nwin) { const int kr = kr0 + i; active = (kr >= myrs) && (kr < myrs + 8); dr = kr - grow; }
        if (__builtin_amdgcn_readfirstlane((int)active)) {
            const LAS unsigned char* Kb = lds + NA_K + buf * 8192; const LAS unsigned char* Vb = lds + NA_V + buf * 8192;
            f32x16 s0 = {0}, s1 = {0};
#pragma unroll
            for (int kk = 0; kk < 4; ++kk) { const bf16x8 ka = *(const LAS bf16x8*)(Kb + na_koff(r32, 2 * kk + hh)), kb = *(const LAS bf16x8*)(Kb + na_koff(32 + r32, 2 * kk + hh));
                s0 = mfma32(ka, qf[kk], s0); s1 = mfma32(kb, qf[kk], s1); }
            if (LAT && i < nwin) { const LAS float* tb = tab + (dr + 7) * 32;
#pragma unroll
                for (int r = 0; r < 16; ++r) { const int kc = crow(r, hh); const int i0 = min(max(kc - qc + 15, 0), 31), i1 = min(max(kc + 32 - qc + 15, 0), 31);
                    s0[r] = (kc >= cs && kc < cs + 16) ? s0[r] * C + tb[i0] : -1e30f; s1[r] = (kc + 32 >= cs && kc + 32 < cs + 16) ? s1[r] * C + tb[i1] : -1e30f; }
            } else { s0 = s0 * C; s1 = s1 * C; }
            float mt = __builtin_fmaxf(s0[0], s1[0]);
#pragma unroll
            for (int r = 1; r < 16; ++r) mt = __builtin_fmaxf(mt, __builtin_fmaxf(s0[r], s1[r]));
            mt = __builtin_fmaxf(mt, __shfl_xor(mt, 32));
            const float mn = __builtin_fmaxf(m_run, mt), alpha = __builtin_amdgcn_exp2f(m_run - mn); m_run = mn;
            float ps = 0.f;
#pragma unroll
            for (int r = 0; r < 16; ++r) { s0[r] = __builtin_amdgcn_exp2f(s0[r] - mn); s1[r] = __builtin_amdgcn_exp2f(s1[r] - mn); ps += s0[r] + s1[r]; }
            l_run = l_run * alpha + ps; o0 = o0 * alpha; o1 = o1 * alpha;
            const bf16x8 pf00 = accfrag(s0, 0), pf01 = accfrag(s0, 1), pf10 = accfrag(s1, 0), pf11 = accfrag(s1, 1);
#pragma unroll
            for (int dt = 0; dt < 2; ++dt) {
#pragma unroll
                for (int ks = 0; ks < 4; ++ks) {
                    const int r0 = 16 * ks + 4 * hh + tq, chunk = 4 * dt + 2 * tg + (tp >> 1);
                    const s16x4 lo = ldtr(Vb + na_voff(r0, chunk) + 8 * (tp & 1)), hi = ldtr(Vb + na_voff(r0 + 8, chunk) + 8 * (tp & 1));
                    const bf16x8 va = cat8(lo, hi); const bf16x8 pf = ks == 0 ? pf00 : ks == 1 ? pf01 : ks == 2 ? pf10 : pf11;
                    if (dt == 0) o0 = mfma32(va, pf, o0); else o1 = mfma32(va, pf, o1); } }
        }
        if (i + 1 < ntile) { *(LAS v4u*)(lds + NA_K + (buf ^ 1) * 8192 + na_koff(skey, sch)) = kreg; *(LAS v4u*)(lds + NA_V + (buf ^ 1) * 8192 + na_voff(skey, sch)) = vreg; }
        __syncthreads();
    }
#undef NA_SRC
    const float inv = __builtin_amdgcn_rcpf(l_run + __shfl_xor(l_run, 32));
#pragma unroll
    for (int dt = 0; dt < 2; ++dt)
#pragma unroll
        for (int g4 = 0; g4 < 4; ++g4) { const int d0 = 32 * dt + 8 * g4 + 4 * hh; const f32x16& o = dt == 0 ? o0 : o1;
            const v2u gt = *(const v2u*)(NA + (size_t)qrow * 2048 + 1536 + 64 * h + d0);
            v2u w; w.x = cvtpk(o[4 * g4 + 0] * inv * bflo(gt.x), o[4 * g4 + 1] * inv * bfhi(gt.x)); w.y = cvtpk(o[4 * g4 + 2] * inv * bflo(gt.y), o[4 * g4 + 3] * inv * bfhi(gt.y));
            *(v2u*)(Y + (size_t)qrow * 1536 + 512 + 64 * h + d0) = w; }
}

constexpr int GL_STRIDE = 136;
constexpr int GL_LQ = 0, GL_LK = 8704, GL_LKT = 17408, GL_LV = 26112, GL_DV = 42496, GL_SSL = 42752, GL_DIR = 43776;
constexpr int GL_WA = 2 * GL_DIR, GL_BA = GL_WA + 8192;
__device__ __forceinline__ float wave_scan_incl(float x, int lane) {
#pragma unroll
    for (int off = 1; off < 64; off <<= 1) { const float y = __shfl_up(x, off); if (lane >= off) x += y; }
    return x;
}
__device__ __forceinline__ bf16x8 ld2x8(const LAS unsigned char* p) { const s16x4 lo = *(const LAS s16x4*)p, hi = *(const LAS s16x4*)(p + 16); return cat8(lo, hi); }
__device__ __forceinline__ void gla_task(const P& p, LAS unsigned char* lds, int layer, bool lat, int b, int h, int tid, int lane, int wave) {
    const bf16* G = (const bf16*)(p.ws + WS_G); const float* LR = (const float*)(p.ws + WS_LR); bf16* Y = (bf16*)(p.ws + WS_Y);
    const int dir = wave >> 2, gw = wave & 3, r32 = lane & 31, hh = lane >> 5;
    const int T = lat ? T_LAT : T_CTX, nch = T / 64, seqbase = lat ? M_CTX + b * T_LAT : b * T_CTX;
    LAS unsigned char* D = lds + dir * GL_DIR;
    LAS float* WA = (LAS float*)(lds + GL_WA); LAS float* BA = (LAS float*)(lds + GL_BA);
    for (int i = tid; i < 2 * 16 * 64; i += 512) { const int d = i >> 10, r = (i >> 6) & 15, kd = i & 63; WA[i] = p.w_alpha[(((size_t)layer * 2 + d) * 16 + r) * 256 + 64 * h + kd]; }
    if (tid < 128) BA[tid] = p.b_alpha[((size_t)layer * 2 + (tid >> 6)) * 256 + 64 * h + (tid & 63)];
    f32x16 S0 = {0}, S1 = {0};
    if (lat) { const float* st = (dir ? p.state_bwd : p.state_fwd) + (((size_t)b * DEPTH + layer) * 4 + h) * 64 * 128 + 32 * gw + r32;
#pragma unroll
        for (int r = 0; r < 16; ++r) { S0[r] = st[(size_t)crow(r, hh) * 128]; S1[r] = st[(size_t)(32 + crow(r, hh)) * 128]; } }
    __syncthreads();
    const int tq = (lane & 15) >> 2, tp = lane & 3, tg = (lane >> 4) & 1;
#pragma nounroll
    for (int c = 0; c < nch; ++c) {
        {
            const int tau = 64 * c + lane; const size_t row = (size_t)(seqbase + (dir ? T - 1 - tau : tau));
            float bc[16];
            { f32x4 l4[4];
#pragma unroll
                for (int j = 0; j < 4; ++j) l4[j] = *(const f32x4*)(LR + row * 32 + 16 * dir + 4 * j);
#pragma unroll
                for (int e = 0; e < 16; ++e) { float z = BA[dir * 64 + 16 * gw + e];
#pragma unroll
                    for (int r = 0; r < 16; ++r) z += l4[r >> 2][r & 3] * WA[(dir * 16 + r) * 64 + 16 * gw + e];
                    const float ls = __builtin_fminf(z, 0.f) - __logf(1.f + __expf(-__builtin_fabsf(z)));
                    bc[e] = wave_scan_incl(ls * 0.0625f, lane); } }
            const v4u q0 = *(const v4u*)(G + row * 1536 + 64 * h + 16 * gw), q1 = *(const v4u*)(G + row * 1536 + 64 * h + 16 * gw + 8);
            const v4u k0 = *(const v4u*)(G + row * 1536 + 256 + 64 * h + 16 * gw), k1 = *(const v4u*)(G + row * 1536 + 256 + 64 * h + 16 * gw + 8);
            const unsigned qw[8] = {q0.x, q0.y, q0.z, q0.w, q1.x, q1.y, q1.z, q1.w}, kw[8] = {k0.x, k0.y, k0.z, k0.w, k1.x, k1.y, k1.z, k1.w};
            unsigned qo[8], ko[8];
#pragma unroll
            for (int e2 = 0; e2 < 8; ++e2) { const float b0 = bc[2 * e2], b1 = bc[2 * e2 + 1]; const float bl0 = __shfl(b0, 63), bl1 = __shfl(b1, 63);
                const float eq0 = __expf(b0), eq1 = __expf(b1), ek0 = __expf(-b0), ek1 = __expf(-b1), el0 = __expf(bl0 - b0), el1 = __expf(bl1 - b1);
                const float kx = bflo(kw[e2]), ky = bfhi(kw[e2]);
                qo[e2] = cvtpk(bflo(qw[e2]) * eq0, bfhi(qw[e2]) * eq1); ko[e2] = cvtpk(kx * ek0, ky * ek1);
                const unsigned kt = cvtpk(kx * el0, ky * el1);
                *(LAS unsigned short*)(D + GL_LKT + (16 * gw + 2 * e2) * GL_STRIDE + 2 * lane) = (unsigned short)(kt & 0xffffu);
                *(LAS unsigned short*)(D + GL_LKT + (16 * gw + 2 * e2 + 1) * GL_STRIDE + 2 * lane) = (unsigned short)(kt >> 16);
                if (lane == 63) { ((LAS float*)(D + GL_DV))[16 * gw + 2 * e2] = __expf(bl0); ((LAS float*)(D + GL_DV))[16 * gw + 2 * e2 + 1] = __expf(bl1); } }
#pragma unroll
            for (int j = 0; j < 4; ++j) { *(LAS v2u*)(D + GL_LQ + lane * GL_STRIDE + 32 * gw + 8 * j) = (v2u){qo[2 * j], qo[2 * j + 1]}; *(LAS v2u*)(D + GL_LK + lane * GL_STRIDE + 32 * gw + 8 * j) = (v2u){ko[2 * j], ko[2 * j + 1]}; }
            const bf16* vs = G + row * 1536 + 512 + 128 * h + 32 * gw;
#pragma unroll
            for (int j = 0; j < 4; ++j) *(LAS v4u*)(D + GL_LV + lane * 256 + ((gw ^ (lane & 3)) << 6) + 16 * j) = *(const v4u*)(vs + 8 * j);
        }
        __syncthreads();
        f32x16 oA, oB;
        {
            bf16x8 Qf[2][4];
#pragma unroll
            for (int ti = 0; ti < 2; ++ti)
#pragma unroll
                for (int ks = 0; ks < 4; ++ks) Qf[ti][ks] = ld2x8(D + GL_LQ + (32 * ti + r32) * GL_STRIDE + (16 * ks + 4 * hh) * 2);
            bf16x8 AF[6];
            {
                f32x16 a00 = {0}, a01 = {0}, a11 = {0};
#pragma unroll
                for (int ks = 0; ks < 4; ++ks) { const bf16x8 k0 = ld2x8(D + GL_LK + r32 * GL_STRIDE + (16 * ks + 4 * hh) * 2), k1 = ld2x8(D + GL_LK + (32 + r32) * GL_STRIDE + (16 * ks + 4 * hh) * 2);
                    a00 = mfma32(k0, Qf[0][ks], a00); a01 = mfma32(k0, Qf[1][ks], a01); a11 = mfma32(k1, Qf[1][ks], a11); }
#pragma unroll
                for (int r = 0; r < 16; ++r) if (crow(r, hh) > r32) { a00[r] = 0.f; a11[r] = 0.f; }
                AF[0] = accfrag(a00, 0); AF[1] = accfrag(a00, 1); AF[2] = accfrag(a01, 0); AF[3] = accfrag(a01, 1); AF[4] = accfrag(a11, 0); AF[5] = accfrag(a11, 1);
            }
            bf16x8 Vf[4];
#pragma unroll
            for (int k4 = 0; k4 < 4; ++k4) { const int r0 = 16 * k4 + 4 * hh + tq; const int cb = 32 * gw + 16 * tg + 4 * tp;
                const int blk = cb >> 5, inner = (cb & 31) * 2;
                const s16x4 lo = ldtr(D + GL_LV + r0 * 256 + ((blk ^ (r0 & 3)) << 6) + inner), hi = ldtr(D + GL_LV + (r0 + 8) * 256 + ((blk ^ ((r0 + 8) & 3)) << 6) + inner);
                Vf[k4] = cat8(lo, hi); }
            {
                const bf16x8 Sf0 = accfrag(S0, 0), Sf1 = accfrag(S0, 1), Sf2 = accfrag(S1, 0), Sf3 = accfrag(S1, 1);
                oA = mfma32(Sf0, Qf[0][0], (f32x16){0}); oA = mfma32(Sf1, Qf[0][1], oA); oA = mfma32(Sf2, Qf[0][2], oA); oA = mfma32(Sf3, Qf[0][3], oA);
                oB = mfma32(Sf0, Qf[1][0], (f32x16){0}); oB = mfma32(Sf1, Qf[1][1], oB); oB = mfma32(Sf2, Qf[1][2], oB); oB = mfma32(Sf3, Qf[1][3], oB);
            }
            oA = mfma32(Vf[0], AF[0], oA); oA = mfma32(Vf[1], AF[1], oA);
            oB = mfma32(Vf[0], AF[2], oB); oB = mfma32(Vf[1], AF[3], oB); oB = mfma32(Vf[2], AF[4], oB); oB = mfma32(Vf[3], AF[5], oB);
            const LAS float* dv = (const LAS float*)(D + GL_DV);
#pragma unroll
            for (int g4 = 0; g4 < 4; ++g4) { const f32x4 d0 = *(const LAS f32x4*)(dv + 8 * g4 + 4 * hh), d1 = *(const LAS f32x4*)(dv + 32 + 8 * g4 + 4 * hh);
#pragma unroll
                for (int e = 0; e < 4; ++e) { S0[4 * g4 + e] *= d0[e]; S1[4 * g4 + e] *= d1[e]; } }
#pragma unroll
            for (int k4 = 0; k4 < 4; ++k4) { const bf16x8 kt0 = ld2x8(D + GL_LKT + r32 * GL_STRIDE + (16 * k4 + 4 * hh) * 2), kt1 = ld2x8(D + GL_LKT + (32 + r32) * GL_STRIDE + (16 * k4 + 4 * hh) * 2);
                S0 = mfma32(kt0, Vf[k4], S0); S1 = mfma32(kt1, Vf[k4], S1); }
        }
        const int tauA = 64 * c + r32; const size_t rowA = (size_t)(seqbase + (dir ? T - 1 - tauA : tauA)), rowB = (size_t)(seqbase + (dir ? T - 1 - (tauA + 32) : tauA + 32));
        bf16* yA = Y + rowA * 1536 + 1024 + 128 * h + 32 * gw + 4 * hh; bf16* yB = Y + rowB * 1536 + 1024 + 128 * h + 32 * gw + 4 * hh;
        if (c < nch / 2) {
#pragma unroll
            for (int g4 = 0; g4 < 4; ++g4) { v2u wa, wb; wa.x = cvtpk(oA[4 * g4], oA[4 * g4 + 1]); wa.y = cvtpk(oA[4 * g4 + 2], oA[4 * g4 + 3]); wb.x = cvtpk(oB[4 * g4], oB[4 * g4 + 1]); wb.y = cvtpk(oB[4 * g4 + 2], oB[4 * g4 + 3]);
                *(v2u*)(yA + 8 * g4) = wa; *(v2u*)(yB + 8 * g4) = wb; }
            VM_WAIT();
            __syncthreads();
        } else {
            float sa = 0.f, sb = 0.f;
#pragma unroll
            for (int g4 = 0; g4 < 4; ++g4) { const unsigned long long pa = __hip_atomic_load((const unsigned long long*)(yA + 8 * g4), RLX_AGENT), pb = __hip_atomic_load((const unsigned long long*)(yB + 8 * g4), RLX_AGENT);
                oA[4 * g4] += bflo((unsigned)pa); oA[4 * g4 + 1] += bfhi((unsigned)pa); oA[4 * g4 + 2] += bflo((unsigned)(pa >> 32)); oA[4 * g4 + 3] += bfhi((unsigned)(pa >> 32));
                oB[4 * g4] += bflo((unsigned)pb); oB[4 * g4 + 1] += bfhi((unsigned)pb); oB[4 * g4 + 2] += bflo((unsigned)(pb >> 32)); oB[4 * g4 + 3] += bfhi((unsigned)(pb >> 32)); }
#pragma unroll
            for (int r = 0; r < 16; ++r) { sa += oA[r] * oA[r]; sb += oB[r] * oB[r]; }
            sa += __shfl_xor(sa, 32); sb += __shfl_xor(sb, 32);
            LAS float* ssl = (LAS float*)(D + GL_SSL);
            if (hh == 0) { ssl[gw * 64 + r32] = sa; ssl[gw * 64 + 32 + r32] = sb; }
            __syncthreads();
            const float ta = (ssl[r32] + ssl[64 + r32]) + (ssl[128 + r32] + ssl[192 + r32]), tb = (ssl[32 + r32] + ssl[96 + r32]) + (ssl[160 + r32] + ssl[224 + r32]);
            const float ra = __builtin_amdgcn_rsqf(ta * (1.f / 128.f) + EPS), rb = __builtin_amdgcn_rsqf(tb * (1.f / 128.f) + EPS);
#pragma unroll
            for (int g4 = 0; g4 < 4; ++g4) { const f32x4 nw = *(const f32x4*)(p.gla_norm_w + layer * 128 + 32 * gw + 8 * g4 + 4 * hh);
                const v2u ga = *(const v2u*)(G + rowA * 1536 + 1024 + 128 * h + 32 * gw + 8 * g4 + 4 * hh), gb = *(const v2u*)(G + rowB * 1536 + 1024 + 128 * h + 32 * gw + 8 * g4 + 4 * hh);
                v2u wa, wb;
                wa.x = cvtpk(oA[4 * g4] * ra * nw[0] * bflo(ga.x), oA[4 * g4 + 1] * ra * nw[1] * bfhi(ga.x)); wa.y = cvtpk(oA[4 * g4 + 2] * ra * nw[2] * bflo(ga.y), oA[4 * g4 + 3] * ra * nw[3] * bfhi(ga.y));
                wb.x = cvtpk(oB[4 * g4] * rb * nw[0] * bflo(gb.x), oB[4 * g4 + 1] * rb * nw[1] * bfhi(gb.x)); wb.y = cvtpk(oB[4 * g4 + 2] * rb * nw[2] * bflo(gb.y), oB[4 * g4 + 3] * rb * nw[3] * bfhi(gb.y));
                *(v2u*)(yA + 8 * g4) = wa; *(v2u*)(yB + 8 * g4) = wb; }
            __syncthreads();
        }
    }
    if (!lat) { float* so = p.out + (dir ? OUT_SB : OUT_SF) + (((size_t)b * DEPTH + layer) * 4 + h) * 64 * 128 + 32 * gw + r32;
#pragma unroll
        for (int r = 0; r < 16; ++r) { so[(size_t)crow(r, hh) * 128] = S0[r] * DBG_SCALE_ST; so[(size_t)(32 + crow(r, hh)) * 128] = S1[r] * DBG_SCALE_ST; } }
}

#ifndef MAXPH
#define MAXPH 999
#endif
#ifndef ZERO_OUT
#define ZERO_OUT 0
#endif
struct Args { P p; };
__global__ void __launch_bounds__(512, 2) fwd_kernel(Args args) {
    extern __shared__ __attribute__((aligned(16))) unsigned char lds_raw[];
    LAS unsigned char* lds = (LAS unsigned char*)lds_raw;
    const P& p = args.p;
    const int tid = threadIdx.x, lane = tid & 63, wave = __builtin_amdgcn_readfirstlane(tid >> 6);
    for (int u = tid; u < (LDS_BYTES - LDSCTL_OFF) / 4; u += 512) ((LAS unsigned*)(lds + LDSCTL_OFF))[u] = 0u;
    __syncthreads();
    gu32* ctl = (gu32*)(p.ws + WS_CTL);
    XcdBarrier bar = xcd_barrier_post((unsigned*)(ctl + CW_BAR), (volatile LAS unsigned*)(lds + MISC_OFF) + 8);
    const int G = gridDim.x;
    int nph = 0;
#define PHASE_END() do { xcd_barrier(bar); if (++nph > MAXPH) return; } while (0)
#if ZERO_OUT
    for (size_t i = (size_t)blockIdx.x * 512 + tid; i < OUT_TOTAL; i += (size_t)G * 512) p.out[i] = 0.f;
#endif
#ifndef NO_P0
    p0a(p, lds, tid, lane, wave);
#endif
    PHASE_END();
#ifndef NO_P0
    p0b(p, lds, tid, lane, wave);
#endif
    PHASE_END();
    bf16* AP = (bf16*)(p.ws + WS_AP); bf16* Yb = (bf16*)(p.ws + WS_Y); bf16* MG = (bf16*)(p.ws + WS_MERGED); bf16* GT = (bf16*)(p.ws + WS_GATES);
#pragma nounroll
    for (int l = 0; l < DEPTH; ++l) {
        const bf16* WB1 = (const bf16*)(p.ws + WS_WB1) + (size_t)l * N1 * DM;
        pg8::EpiG1 E1{l, 0, p.ws, p.out, p.q_norm_w + l * 64, p.k_norm_w + l * 64};
        { pg8::Gemm g{AP, WB1, MROWS, TILE_GATE0 * 256, DM}; pg8::StaticOrder S; S.init(MROWS, TILE_GATE0 * 256, G, (int)blockIdx.x);
#ifndef NO_G1
          pg8::gemm_phase<pg8::EpiG1, pg8::StaticOrder, true, true>(lds, g, S, E1);
#endif
        }
        PHASE_END();
        {
            const int bx = blockIdx.x;
#pragma nounroll
            for (int it = bx < 32 ? bx : bx, st = bx < 32 ? 100000 : G - 32; it < 32 + 1024; it += st) {
                int tid_m = threadIdx.x; asm volatile("" : "+v"(tid_m));
                const int lane_m = tid_m & 63, wave_m = __builtin_amdgcn_readfirstlane(tid_m >> 6);
                const int j = it - 32;
                if (it < 32 || (j >= 512 && j < 576)) {
#ifndef NO_GLA
                    const bool lat = it < 32; const int q = lat ? it : j - 512;
                    gla_task(p, lds, l, lat, q >> 2, q & 3, tid_m, lane_m, wave_m);
#endif
                } else if (j < 512) {
#ifndef NO_NA
                    na_unit<true>(p, lds, l, j >> 6, (j >> 3) & 7, j & 7, tid_m, lane_m, wave_m);
#endif
                } else if (j < 704) {
#ifndef NO_NA
                    const int q = j - 576; na_unit<false>(p, lds, l, q >> 3, q & 7, 0, tid_m, lane_m, wave_m);
#endif
                } else {
#ifndef NO_CONV
                    conv_unit(p, l, j - 704, tid_m);
#endif
                }
                __syncthreads();
            }
        }
        PHASE_END();
        { pg8::EpiG1 Eg = E1; Eg.tile0 = TILE_GATE0;
          pg8::Gemm g{AP, WB1 + (size_t)TILE_GATE0 * 256 * DM, MROWS, 12 * 256, DM}; pg8::StaticOrder S; S.init(MROWS, 12 * 256, G, (int)blockIdx.x);
#ifndef NO_GG
          pg8::gemm_phase<pg8::EpiG1, pg8::StaticOrder, true, true>(lds, g, S, Eg);
#endif
        }
        PHASE_END();
        { pg8::Gemm g{Yb, (const bf16*)(p.ws + WS_WB2) + (size_t)l * DM * 1536, MROWS, DM, 1536}; pg8::StaticOrder S; S.init(MROWS, DM, G, (int)blockIdx.x);
          pg8::EpiG2 E2{GT, MG};
#ifndef NO_G2
          pg8::gemm_phase<pg8::EpiG2, pg8::StaticOrder, true, true>(lds, g, S, E2);
#endif
        }
        PHASE_END();
        { pg8::Gemm g{MG, (const bf16*)(p.ws + WS_WB3) + (size_t)l * DM * DM, MROWS, DM, DM}; pg8::StaticOrder S; S.init(MROWS, DM, G, (int)blockIdx.x);
          pg8::EpiG3 E3{l == 0 ? p.x_prompt : p.out + OUT_X, l == 0 ? p.x_sample : p.out + OUT_X + (size_t)M_CTX * DM, p.out + OUT_X,
                        (const float*)(p.ws + WS_GATEM) + (size_t)l * NMOD * DM, l + 1 < DEPTH ? (const float*)(p.ws + WS_WEFF) + (size_t)(l + 1) * NMOD * DM : nullptr,
                        AP, (float*)(p.ws + WS_SSP)};
#ifndef NO_G3
          pg8::gemm_phase<pg8::EpiG3, pg8::StaticOrder, true, true>(lds, g, S, E3);
#endif
        }
        if (l + 1 < DEPTH) PHASE_END();
    }
}

extern "C" void kernel_launch(void* const* d_in, const int* in_sizes, int n_in, void* d_out, int out_size, void* d_ws, size_t ws_size, hipStream_t stream) {
    static int grid = 0;
    if (grid == 0) {
        if (n_in != 23 || (size_t)out_size != OUT_TOTAL || ws_size < WS_END) { fprintf(stderr, "kernel_launch: unexpected shapes (n_in %d out %d ws %zu)\n", n_in, out_size, ws_size); grid = -1; return; }
        int dev = 0, cus = 0;
        if (hipGetDevice(&dev) != hipSuccess || hipDeviceGetAttribute(&cus, hipDeviceAttributeMultiprocessorCount, dev) != hipSuccess) { grid = -1; return; }
        if (hipFuncSetAttribute((const void*)fwd_kernel, hipFuncAttributeMaxDynamicSharedMemorySize, LDS_BYTES) != hipSuccess) { grid = -1; return; }
        (void)hipGetLastError();
        grid = cus;
        if (grid != 256) fprintf(stderr, "kernel_launch: %d CUs (built for 256)\n", grid);
    }
    if (grid < 0) return;
    if (hipMemsetAsync((char*)d_ws + WS_CTL, 0, CTL_ZERO_BYTES, stream) != hipSuccess) return;
    Args a{};
    const float** f = (const float**)&a.p;
    for (int i = 0; i < 23; ++i) f[i] = (const float*)d_in[i];
    a.p.out = (float*)d_out; a.p.ws = (unsigned char*)d_ws;
    hipLaunchKernelGGL(fwd_kernel, dim3(grid), dim3(512), LDS_BYTES, stream, a);
}
```

```cpp
#include <hip/hip_runtime.h>
#include <cstdio>
#include <cstdint>
#ifndef DBG_SCALE
#define DBG_SCALE 1.0f
#endif
#ifndef DBG_SCALE_ST
#define DBG_SCALE_ST 1.0f
#endif
constexpr int DM = 1024, DEPTH = 4, NB_CTX = 16, T_CTX = 256, NB_LAT = 8, T_LAT = 2048, PAST = 512;
constexpr int M_CTX = NB_CTX * T_CTX, M_LAT = NB_LAT * T_LAT, MROWS = M_CTX + M_LAT;
constexpr int NT1 = 35, N1 = NT1 * 256;
constexpr int TILE_LR = 22, TILE_GATE0 = 23;
constexpr int NMOD = 9;
constexpr float EPS = 1e-6f, LOG2E = 1.4426950408889634f;
constexpr size_t OUT_X = 0, OUT_CK = 20971520, OUT_CV = 29360128, OUT_SF = 37748736, OUT_SB = 39845888, OUT_TOTAL = 41943040;
constexpr size_t MiB = 1u << 20;
constexpr size_t WS_CTL = 0, CTL_ZERO_BYTES = 1 * MiB;
constexpr size_t WS_MODP = 1 * MiB;
constexpr size_t WS_WEFF = 5 * MiB;
constexpr size_t WS_GATEM = 5 * MiB + 256 * 1024;
constexpr size_t WS_BIASV = 6 * MiB;
constexpr size_t WS_SSP = 8 * MiB;
constexpr size_t WS_WB1 = 10 * MiB;
constexpr size_t WS_WB2 = 80 * MiB;
constexpr size_t WS_WB3 = 92 * MiB;
constexpr size_t WS_CKB = 100 * MiB, WS_CVB = 116 * MiB;
constexpr size_t WS_AP = 132 * MiB;
constexpr size_t WS_CONVIN = 172 * MiB;
constexpr size_t WS_NA = 252 * MiB;
constexpr size_t WS_G = 332 * MiB;
constexpr size_t WS_LR = 392 * MiB;
constexpr size_t WS_Y = 396 * MiB;
constexpr size_t WS_GATES = WS_CONVIN;
constexpr size_t WS_MERGED = WS_G;
constexpr size_t WS_OGLA = 456 * MiB;
constexpr size_t WS_END = 496 * MiB;
static_assert(WS_GATES + (size_t)MROWS * 3072 * 2 <= WS_G && WS_MERGED + (size_t)MROWS * 1024 * 2 <= WS_LR && WS_Y + (size_t)MROWS * 1536 * 2 <= WS_OGLA && WS_OGLA + (size_t)2 * MROWS * 512 * 2 <= WS_END, "ws map");
constexpr int CW_BAR = 4096;
constexpr int RING_BYTES = 131072, LDSCTL_OFF = RING_BYTES, MISC_OFF = LDSCTL_OFF + 320, LDS_BYTES = 147456;

#define GAS __attribute__((address_space(1)))
#define LAS __attribute__((address_space(3)))
typedef unsigned short bf16;
typedef unsigned v4u __attribute__((ext_vector_type(4)));
typedef unsigned v2u __attribute__((ext_vector_type(2)));
typedef float f32x4 __attribute__((ext_vector_type(4)));
typedef float f32x16 __attribute__((ext_vector_type(16)));
typedef short bf16x8 __attribute__((ext_vector_type(8)));
typedef short s16x4 __attribute__((ext_vector_type(4)));
typedef GAS unsigned gu32;
#define RLX_AGENT __ATOMIC_RELAXED, __HIP_MEMORY_SCOPE_AGENT
#define LDS_WAIT() asm volatile("s_waitcnt lgkmcnt(0)" ::: "memory")
#define VM_WAIT() asm volatile("s_waitcnt vmcnt(0)" ::: "memory")
__device__ __forceinline__ unsigned f2bf(float f) { unsigned u = __builtin_bit_cast(unsigned, f); return (u + 0x7fffu + ((u >> 16) & 1u)) >> 16; }
__device__ __forceinline__ unsigned pk2(float lo, float hi) { return f2bf(lo) | (f2bf(hi) << 16); }
__device__ __forceinline__ float bflo(unsigned w) { return __builtin_bit_cast(float, w << 16); }
__device__ __forceinline__ float bfhi(unsigned w) { return __builtin_bit_cast(float, w & 0xffff0000u); }
__device__ __forceinline__ float fsigmoid(float x) { return __builtin_amdgcn_rcpf(1.f + __expf(-x)); }
__device__ __forceinline__ float fsilu(float x) { return x * fsigmoid(x); }

__host__ __device__ __forceinline__ void wb1_src(int nidx, int& mat, int& col) {
    const int tile = nidx >> 8, s = nidx & 255, bj = s >> 7, wc = (s >> 5) & 3, nn = (s >> 4) & 1, fq = (s >> 2) & 3, j = s & 3;
    const int pcol = 128 * bj + 32 * wc + 8 * fq + 4 * nn + j;
    mat = 0;
    if (tile < 8) col = 256 * tile + pcol;
    else if (tile < 12) col = (tile < 10 ? 2048 : 2560) + 64 * (4 * (tile & 1) + wc) + 32 * bj + 8 * fq + 4 * nn + j;
    else if (tile < 16) col = 3072 + 256 * (tile - 12) + pcol;
    else if (tile < 18) col = 4096 + 256 * (tile - 16) + 64 * wc + 32 * bj + 16 * nn + 4 * fq + j;
    else if (tile < 22) col = 4608 + 256 * (tile - 18) + pcol;
    else if (tile == TILE_LR) { if (s < 32) col = 5632 + s; else { mat = -1; col = 0; } }
    else { mat = 1; col = 256 * (tile - TILE_GATE0) + pcol; }
}
__host__ __device__ __forceinline__ int pcol_of_slot(int s) { const int bj = s >> 7, wc = (s >> 5) & 3, nn = (s >> 4) & 1, fq = (s >> 2) & 3, j = s & 3; return 128 * bj + 32 * wc + 8 * fq + 4 * nn + j; }


namespace pg8 {
#define PG8_LAS __attribute__((address_space(3)))
typedef unsigned short bf16_t;
typedef short bf16x8 __attribute__((ext_vector_type(8)));
typedef float f32x4 __attribute__((ext_vector_type(4)));
typedef unsigned u32x4 __attribute__((ext_vector_type(4)));
constexpr int BM = 256, BK = 64, HALF = 128, HTB = HALF * BK * 2  , STAGE_BYTES = 8 * HTB, NXCD = 8, WGM = 8;

__host__ __device__ __forceinline__ int lds_byte(int r, int c) { const int st = (r >> 4) * 2 + (c >> 5), rr = r & 15, cc = c & 31, ob = rr * 64 + cc * 2; return st * 1024 + (ob ^ (((ob >> 9) & 1) << 5)); }
__host__ __device__ __forceinline__ void stage_rc(int b, int& R, int& C) { const int st = b / 1024, sb = b % 1024, swz = sb ^ (((sb >> 9) & 1) << 5); R = (st >> 1) * 16 + swz / 64; C = (st & 1) * 32 + (swz % 64) / 2; }
__host__ __device__ __forceinline__ int perm32(int rho) { const int n = rho >> 4, i = rho & 15; return 8 * (i >> 2) + 4 * n + (i & 3); }

struct Unit { int pm, pn; };
struct Gemm { const bf16_t* A; const bf16_t* Bt; int M, N, K; };

struct StaticOrder {
    int nM, nN, nwg, G, c;
    __host__ __device__ void init(int M, int N, int G_, int c_) { nM = M / BM; nN = N / BM; nwg = nM * nN; G = G_; c = c_; }
    __host__ __device__ bool next(int i, Unit& u) const {
        const long L = (long)i * G + c; if (L >= nwg) return false;
        int wgid = (int)L; { const int q = nwg / NXCD, r = nwg % NXCD, xcd = wgid % NXCD, off = wgid / NXCD; wgid = (xcd < r ? xcd * (q + 1) : r * (q + 1) + (xcd - r) * q) + off; }
        const int nig = WGM * nN, gid = wgid / nig, fm = gid * WGM, gsz = (nM - fm) < WGM ? (nM - fm) : WGM;
        u.pm = fm + ((wgid % nig) % gsz); u.pn = (wgid % nig) / gsz; return true;
    }
    __device__ __forceinline__ void a_ready(const Unit&) const {}
    __device__ __forceinline__ void done(const Unit&) const {}
};


typedef float f32x2_t __attribute__((ext_vector_type(2))); typedef __bf16 bf16x2_t __attribute__((ext_vector_type(2)));
__device__ __forceinline__ unsigned cvt_pk_bf16(float lo, float hi) { f32x2_t v = {lo, hi}; bf16x2_t b = __builtin_convertvector(v, bf16x2_t); return __builtin_bit_cast(unsigned, b); }
typedef unsigned u32x2 __attribute__((ext_vector_type(2)));

struct EpiG1 {
    static constexpr bool PERM = false, AFTER_DRAIN = false, MID = false; static constexpr int MID_T0 = 0, MID_T1 = 0;
    int layer, tile0;
    unsigned char* wsb; float* outb;
    const float *qnw, *knw;
    __device__ __forceinline__ void operator()(const f32x4 (&acc)[2][2][4][2], const Unit& u, int wr, int wc, int fr, int fq) const {
        const float* ssp = (const float*)(wsb + WS_SSP); const float* biasv = (const float*)(wsb + WS_BIASV) + (size_t)layer * NMOD * N1;
        bf16_t* convin = (bf16_t*)(wsb + WS_CONVIN); bf16_t* na = (bf16_t*)(wsb + WS_NA); bf16_t* g = (bf16_t*)(wsb + WS_G); bf16_t* gates = (bf16_t*)(wsb + WS_GATES); float* lr = (float*)(wsb + WS_LR);
        float* out_ck = outb + OUT_CK; float* out_cv = outb + OUT_CV;
        const int tile = tile0 + u.pn;
        const int bi = u.pm < 16 ? 0 : 1 + ((u.pm - 16) >> 3);
        int rowb = u.pm * BM + wr * 64 + fr; asm volatile("" : "+v"(rowb));
        f32x4 bv[2][2];
#pragma unroll
        for (int bj = 0; bj < 2; ++bj)
#pragma unroll
            for (int n = 0; n < 2; ++n) bv[bj][n] = *(const f32x4*)(biasv + (size_t)bi * N1 + tile * 256 + 128 * bj + 32 * wc + 16 * n + 4 * fq);
#define G1_RINV(r) ({ const f32x4 p_ = *(const f32x4*)(ssp + (size_t)(r) * 16 + 4 * fq); float s_ = (p_[0] + p_[1]) + (p_[2] + p_[3]); s_ += __shfl_xor(s_, 16); s_ += __shfl_xor(s_, 32); __builtin_amdgcn_rsqf(s_ * (1.0f / 1024.0f) + EPS); })
        if (tile < 8 || (tile >= 12 && tile < 16) || (tile >= 18 && tile < 22) || tile >= TILE_GATE0) {
            bf16_t* dst; int pitch, colt, act;
            if (tile < 8) { dst = convin; pitch = 2048; colt = 256 * tile; act = tile >= 6 ? 1 : 0; }
            else if (tile < 16) { dst = na; pitch = 2048; colt = 1024 + 256 * (tile - 12); act = tile >= 14 ? 1 : 0; }
            else if (tile < 22) { dst = g; pitch = 1536; colt = 512 + 256 * (tile - 18); act = tile >= 20 ? 1 : 0; }
            else { dst = gates; pitch = 3072; colt = 256 * (tile - TILE_GATE0); act = 2; }
            const bool cv = (tile == 12 || tile == 13) && u.pm < 16;
#pragma unroll
            for (int ai = 0; ai < 2; ++ai)
#pragma unroll
                for (int m = 0; m < 4; ++m) { const int r = rowb + 128 * ai + 16 * m; const float ri = G1_RINV(r);
#pragma unroll
                    for (int bj = 0; bj < 2; ++bj) { f32x4 v0 = acc[ai][bj][m][0] * ri + bv[bj][0], v1 = acc[ai][bj][m][1] * ri + bv[bj][1];
                        if (act == 1) {
#pragma unroll
                            for (int j = 0; j < 4; ++j) { v0[j] = fsilu(v0[j]); v1[j] = fsilu(v1[j]); } }
                        else if (act == 2) {
#pragma unroll
                            for (int j = 0; j < 4; ++j) { v0[j] = fsigmoid(v0[j]); v1[j] = fsigmoid(v1[j]); } }
                        const int c8 = 128 * bj + 32 * wc + 8 * fq;
                        u32x4 w; w.x = cvt_pk_bf16(v0[0], v0[1]); w.y = cvt_pk_bf16(v0[2], v0[3]); w.z = cvt_pk_bf16(v1[0], v1[1]); w.w = cvt_pk_bf16(v1[2], v1[3]);
                        *(u32x4*)(dst + (size_t)r * pitch + colt + c8) = w;
                        if (cv) { const int c = 256 * (tile - 12) + c8, head = c >> 6, d = c & 63;
                            float* o = out_cv + ((((size_t)u.pm * DEPTH + layer) * 8 + head) * 256 + (r & 255)) * 64 + d;
                            *(f32x4*)o = v0 * DBG_SCALE; *(f32x4*)(o + 4) = v1 * DBG_SCALE; } }
                    asm volatile("" ::: "memory"); }
        } else if (tile < 12) {
            const bool isk = tile >= 10; const float* nw = isk ? knw : qnw; const int head = 4 * (tile & 1) + wc;
            f32x4 w0[2], w1[2];
#pragma unroll
            for (int bj = 0; bj < 2; ++bj) { w0[bj] = *(const f32x4*)(nw + 32 * bj + 8 * fq); w1[bj] = *(const f32x4*)(nw + 32 * bj + 8 * fq + 4); }
#pragma unroll
            for (int ai = 0; ai < 2; ++ai)
#pragma unroll
                for (int m = 0; m < 4; ++m) { const int r = rowb + 128 * ai + 16 * m; const float ri = G1_RINV(r);
                    f32x4 v[2][2]; float ss = 0.f;
#pragma unroll
                    for (int bj = 0; bj < 2; ++bj)
#pragma unroll
                        for (int n = 0; n < 2; ++n) { v[bj][n] = acc[ai][bj][m][n] * ri + bv[bj][n]; ss += (v[bj][n][0] * v[bj][n][0] + v[bj][n][1] * v[bj][n][1]) + (v[bj][n][2] * v[bj][n][2] + v[bj][n][3] * v[bj][n][3]); }
                    ss += __shfl_xor(ss, 16); ss += __shfl_xor(ss, 32);
                    const float rn = __builtin_amdgcn_rsqf(ss * (1.0f / 64.0f) + EPS);
#pragma unroll
                    for (int bj = 0; bj < 2; ++bj) { const f32x4 a = v[bj][0] * rn * w0[bj], b = v[bj][1] * rn * w1[bj];
                        u32x4 w; w.x = cvt_pk_bf16(a[0], a[1]); w.y = cvt_pk_bf16(a[2], a[3]); w.z = cvt_pk_bf16(b[0], b[1]); w.w = cvt_pk_bf16(b[2], b[3]);
                        *(u32x4*)(na + (size_t)r * 2048 + (isk ? 512 : 0) + 64 * head + 32 * bj + 8 * fq) = w;
                        if (isk && u.pm < 16) { float* o = out_ck + ((((size_t)u.pm * DEPTH + layer) * 8 + head) * 256 + (r & 255)) * 64 + 32 * bj + 8 * fq;
                            *(f32x4*)o = a * DBG_SCALE; *(f32x4*)(o + 4) = b * DBG_SCALE; } }
                    asm volatile("" ::: "memory"); }
        } else if (tile < 18) {
            const bool isq = tile == 16; const bool lat = u.pm >= 16; const float qs = isq ? 0.125f : 1.0f;
            float inv[4];
#pragma unroll
            for (int j = 0; j < 4; ++j) inv[j] = __builtin_amdgcn_exp2f(-(float)(4 * fq + j) * 0.83048202372184059f) * 0.15915494309189535f;
#pragma unroll
            for (int ai = 0; ai < 2; ++ai)
#pragma unroll
                for (int m = 0; m < 4; ++m) { const int r = rowb + 128 * ai + 16 * m; const float ri = G1_RINV(r);
                    float prow = (float)(4 * ((u.pm - 16) & 7) + 2 * ai + wr), pcolf = (float)(16 * m + fr); asm volatile("" : "+v"(prow), "+v"(pcolf));
#pragma unroll
                    for (int bj = 0; bj < 2; ++bj) { f32x4 a = acc[ai][bj][m][0] * ri + bv[bj][0], b = acc[ai][bj][m][1] * ri + bv[bj][1];
                        if (lat) { const float pos = bj == 0 ? prow : pcolf;
#pragma unroll
                            for (int j = 0; j < 4; ++j) { const float t = pos * inv[j], sn = __builtin_amdgcn_sinf(t), cs = __builtin_amdgcn_cosf(t); const float x = a[j], y = b[j]; a[j] = x * cs - y * sn; b[j] = x * sn + y * cs; } }
                        a = a * qs; b = b * qs;
                        bf16_t* o = g + (size_t)r * 1536 + 256 * (tile - 16) + 64 * wc + 32 * bj + 4 * fq;
                        u32x2 wa, wb; wa.x = cvt_pk_bf16(a[0], a[1]); wa.y = cvt_pk_bf16(a[2], a[3]); wb.x = cvt_pk_bf16(b[0], b[1]); wb.y = cvt_pk_bf16(b[2], b[3]);
                        *(u32x2*)o = wa; *(u32x2*)(o + 16) = wb; }
                    asm volatile("" ::: "memory"); }
        } else {
            if (wc == 0) {
#pragma unroll
                for (int ai = 0; ai < 2; ++ai)
#pragma unroll
                    for (int m = 0; m < 4; ++m) { const int r = rowb + 128 * ai + 16 * m; const float ri = G1_RINV(r);
#pragma unroll
                        for (int n = 0; n < 2; ++n) *(f32x4*)(lr + (size_t)r * 32 + 16 * n + 4 * fq) = acc[ai][0][m][n] * ri + bv[0][n]; } }
        }
    }
};

struct EpiG2 {
    static constexpr bool PERM = false, AFTER_DRAIN = false, MID = true; static constexpr int MID_T0 = 8, MID_T1 = 16;
    const bf16_t* gates; bf16_t* merged;
    static __device__ __forceinline__ float cl(float x) { return __builtin_fmaxf(x, 1e-6f); }
    __device__ __forceinline__ void mid(f32x4 (&acc)[2][2][4][2], const Unit& u, int seg, int wr, int wc, int fr, int fq) const {
        int rowb = u.pm * BM + wr * 64 + fr; asm volatile("" : "+v"(rowb));
#pragma unroll
        for (int ai = 0; ai < 2; ++ai)
#pragma unroll
            for (int m = 0; m < 4; ++m) { const bf16_t* gp = gates + (size_t)(rowb + 128 * ai + 16 * m) * 3072 + seg * 1024 + u.pn * 256 + 32 * wc + 8 * fq;
#pragma unroll
                for (int bj = 0; bj < 2; ++bj) { const u32x4 ga = *(const u32x4*)(gp + 128 * bj), gb = *(const u32x4*)(gp + 1024 + 128 * bj);
                    f32x4 r0, r1;
                    r0[0] = cl(bflo(ga.x)) * __builtin_amdgcn_rcpf(cl(bflo(gb.x))); r0[1] = cl(bfhi(ga.x)) * __builtin_amdgcn_rcpf(cl(bfhi(gb.x)));
                    r0[2] = cl(bflo(ga.y)) * __builtin_amdgcn_rcpf(cl(bflo(gb.y))); r0[3] = cl(bfhi(ga.y)) * __builtin_amdgcn_rcpf(cl(bfhi(gb.y)));
                    r1[0] = cl(bflo(ga.z)) * __builtin_amdgcn_rcpf(cl(bflo(gb.z))); r1[1] = cl(bfhi(ga.z)) * __builtin_amdgcn_rcpf(cl(bfhi(gb.z)));
                    r1[2] = cl(bflo(ga.w)) * __builtin_amdgcn_rcpf(cl(bflo(gb.w))); r1[3] = cl(bfhi(ga.w)) * __builtin_amdgcn_rcpf(cl(bfhi(gb.w)));
                    acc[ai][bj][m][0] *= r0; acc[ai][bj][m][1] *= r1; }
                asm volatile("" ::: "memory"); }
    }
    __device__ __forceinline__ void operator()(const f32x4 (&acc)[2][2][4][2], const Unit& u, int wr, int wc, int fr, int fq) const {
        int rowb = u.pm * BM + wr * 64 + fr; asm volatile("" : "+v"(rowb));
#pragma unroll
        for (int ai = 0; ai < 2; ++ai)
#pragma unroll
            for (int m = 0; m < 4; ++m) { const size_t r = (size_t)(rowb + 128 * ai + 16 * m); const int c8 = u.pn * 256 + 32 * wc + 8 * fq;
#pragma unroll
                for (int bj = 0; bj < 2; ++bj) { const u32x4 gc = *(const u32x4*)(gates + r * 3072 + 2048 + c8 + 128 * bj);
                    const f32x4 a = acc[ai][bj][m][0], b = acc[ai][bj][m][1];
                    u32x4 w; w.x = cvt_pk_bf16(a[0] * cl(bflo(gc.x)), a[1] * cl(bfhi(gc.x))); w.y = cvt_pk_bf16(a[2] * cl(bflo(gc.y)), a[3] * cl(bfhi(gc.y)));
                    w.z = cvt_pk_bf16(b[0] * cl(bflo(gc.z)), b[1] * cl(bfhi(gc.z))); w.w = cvt_pk_bf16(b[2] * cl(bflo(gc.w)), b[3] * cl(bfhi(gc.w)));
                    *(u32x4*)(merged + r * 1024 + c8 + 128 * bj) = w; }
                asm volatile("" ::: "memory"); }
    }
};

struct EpiG3 {
    static constexpr bool PERM = false, AFTER_DRAIN = false, MID = false; static constexpr int MID_T0 = 0, MID_T1 = 0;
    const float* xin_ctx; const float* xin_lat;
    float* xout; const float* gatem; const float* weffn; bf16_t* ap; float* ssp;
    __device__ __forceinline__ void operator()(const f32x4 (&acc)[2][2][4][2], const Unit& u, int wr, int wc, int fr, int fq) const {
        const int bi = u.pm < 16 ? 0 : 1 + ((u.pm - 16) >> 3);
        int rowb = u.pm * BM + wr * 64 + fr; asm volatile("" : "+v"(rowb));
        const float* xin = u.pm < 16 ? xin_ctx : xin_lat - (size_t)M_CTX * DM;
        f32x4 gm[2][2], wn[2][2];
#pragma unroll
        for (int bj = 0; bj < 2; ++bj)
#pragma unroll
            for (int n = 0; n < 2; ++n) { const int c = u.pn * 256 + 128 * bj + 32 * wc + 16 * n + 4 * fq; gm[bj][n] = *(const f32x4*)(gatem + bi * DM + c);
                wn[bj][n] = weffn ? *(const f32x4*)(weffn + bi * DM + c) : (f32x4){0.f, 0.f, 0.f, 0.f}; }
#pragma unroll
        for (int ai = 0; ai < 2; ++ai)
#pragma unroll
            for (int m = 0; m < 4; ++m) { const size_t r = (size_t)(rowb + 128 * ai + 16 * m); float ssq = 0.f;
#pragma unroll
                for (int bj = 0; bj < 2; ++bj)
#pragma unroll
                    for (int n = 0; n < 2; ++n) { const int c = u.pn * 256 + 128 * bj + 32 * wc + 16 * n + 4 * fq;
                        const f32x4 x = *(const f32x4*)(xin + r * DM + c); const f32x4 xn = x + gm[bj][n] * acc[ai][bj][m][n];
                        *(f32x4*)(xout + r * DM + c) = xn;
                        if (weffn) { ssq += (xn[0] * xn[0] + xn[1] * xn[1]) + (xn[2] * xn[2] + xn[3] * xn[3]); const f32x4 a = xn * wn[bj][n];
                            u32x2 w; w.x = cvt_pk_bf16(a[0], a[1]); w.y = cvt_pk_bf16(a[2], a[3]); *(u32x2*)(ap + r * DM + c) = w; } }
                if (weffn) { ssq += __shfl_xor(ssq, 16); ssq += __shfl_xor(ssq, 32); if (fq == 0) ssp[r * 16 + 4 * u.pn + wc] = ssq; }
                asm volatile("" ::: "memory"); }
    }
};

template <class Epi, class Sched, bool ALIGN_EPI = false, bool SP2 = false>
__device__ __forceinline__ void gemm_phase(PG8_LAS unsigned char* lds, const Gemm g, const Sched& S, const Epi& E) {
    int tid = threadIdx.x; asm volatile("" : "+v"(tid));
    const int wid = __builtin_amdgcn_readfirstlane(tid >> 6), lane = tid & 63, wr = wid >> 2, wc = wid & 3, fr = lane & 15, fq = lane >> 4;
    const int K = g.K, nt = K / BK;
    unsigned voffA[2], voffB[2];
#pragma unroll
    for (int i = 0; i < 2; ++i) { int R, C; stage_rc(tid * 16 + i * 8192, R, C); const int Rb = Epi::PERM ? ((R & ~31) + perm32(R & 31)) : R;
        voffA[i] = (unsigned)(R * K + C) * 2u; voffB[i] = (unsigned)(Rb * K + C) * 2u; }
    const size_t kstep = (size_t)(BK * 2);
    const size_t hstep = (size_t)HALF * K * 2;
    const size_t tstep = 2 * hstep;
    const unsigned ldsw = (unsigned)wid * 1024u;
    const int aoff = lds_byte(wr * 64 + fr, fq * 8), boff = lds_byte(wc * 32 + fr, fq * 8);
#define PG8_SA(b, h) (((b) * 2 + (h)) * HTB)
#define PG8_SB(b, h) ((4 + (b) * 2 + (h)) * HTB)
#define PG8_STAGE(bufoff, gbase, voff) do { _Pragma("unroll") for (int _i = 0; _i < 2; ++_i) \
        __builtin_amdgcn_global_load_lds((const unsigned*)((const char*)(gbase) + (voff)[_i]), (PG8_LAS unsigned*)(lds + (bufoff) + ldsw + _i * 8192), 16, 0, 0); } while (0)
#define PG8_LDA(dst, b, h) do { _Pragma("unroll") for (int m = 0; m < 4; ++m) _Pragma("unroll") for (int k = 0; k < 2; ++k) dst[m][k] = *(const PG8_LAS bf16x8*)(lds + PG8_SA(b, h) + aoff + m * 2048 + k * 1024); } while (0)
#define PG8_LDB(dst, b, h) do { _Pragma("unroll") for (int n = 0; n < 2; ++n) _Pragma("unroll") for (int k = 0; k < 2; ++k) dst[n][k] = *(const PG8_LAS bf16x8*)(lds + PG8_SB(b, h) + boff + n * 2048 + k * 1024); } while (0)
#define PG8_MMA(ai, bj, At, Bt) do { __builtin_amdgcn_s_setprio(1); _Pragma("unroll") for (int m = 0; m < 4; ++m) _Pragma("unroll") for (int n = 0; n < 2; ++n) _Pragma("unroll") for (int k = 0; k < 2; ++k) \
        acc[ai][bj][m][n] = __builtin_amdgcn_mfma_f32_16x16x32_bf16(Bt[n][k], At[m][k], acc[ai][bj][m][n], 0, 0, 0); __builtin_amdgcn_s_setprio(0); } while (0)
#define PG8_WAIT_V(n) asm volatile("s_waitcnt vmcnt(" #n ")" ::: "memory")
#define PG8_WAIT_L(n) asm volatile("s_waitcnt lgkmcnt(" #n ")" ::: "memory")
#define PG8_BAR __builtin_amdgcn_s_barrier()
#define PG8_SCHED __builtin_amdgcn_sched_barrier(0)
    Unit cur, nxt; int ui = 0;
    if (!S.next(0, cur)) return;
    f32x4 acc[2][2][4][2];
#pragma unroll
    for (int a = 0; a < 2; ++a)
#pragma unroll
        for (int b = 0; b < 2; ++b)
#pragma unroll
            for (int m = 0; m < 4; ++m)
#pragma unroll
                for (int n = 0; n < 2; ++n) acc[a][b][m][n] = (f32x4){0.f, 0.f, 0.f, 0.f};
    bf16x8 At[4][2], B0[2][2], B1[2][2];
    const char* cA = (const char*)g.A + (size_t)cur.pm * tstep; const char* cB = (const char*)g.Bt + (size_t)cur.pn * tstep;
    S.a_ready(cur);
    if constexpr (SP2) {
        PG8_STAGE(PG8_SB(0, 0), cB, voffB); PG8_STAGE(PG8_SB(0, 1), cB + hstep, voffB); PG8_STAGE(PG8_SA(0, 0), cA, voffA); PG8_STAGE(PG8_SA(0, 1), cA + hstep, voffA);
        if (wr == 1) PG8_BAR;
        PG8_WAIT_V(2); PG8_BAR;
        PG8_STAGE(PG8_SB(1, 0), cB + kstep, voffB); PG8_STAGE(PG8_SA(1, 0), cA + kstep, voffA); PG8_STAGE(PG8_SB(1, 1), cB + hstep + kstep, voffB);
        PG8_WAIT_V(6); PG8_BAR;
    } else {
        PG8_STAGE(PG8_SB(0, 0), cB, voffB); PG8_STAGE(PG8_SA(0, 0), cA, voffA); PG8_STAGE(PG8_SB(0, 1), cB + hstep, voffB); PG8_STAGE(PG8_SA(0, 1), cA + hstep, voffA);
        if (wr == 1) PG8_BAR;
        PG8_WAIT_V(4); PG8_BAR;
        PG8_STAGE(PG8_SB(1, 0), cB + kstep, voffB); PG8_STAGE(PG8_SA(1, 0), cA + kstep, voffA); PG8_STAGE(PG8_SB(1, 1), cB + hstep + kstep, voffB);
        PG8_WAIT_V(6); PG8_BAR;
    }
    for (;;) {
        const bool has_next = S.next(ui + 1, nxt);
        const char* nA = has_next ? (const char*)g.A + (size_t)nxt.pm * tstep : cA; const char* nB = has_next ? (const char*)g.Bt + (size_t)nxt.pn * tstep : cB;
        for (int t = 0; t < nt; t += 2) {
            const bool last = (t == nt - 2);
            const char* a1 = cA + (size_t)(t + 1) * kstep;
            const char* a2 = last ? nA : cA + (size_t)(t + 2) * kstep; const char* b2 = last ? nB : cB + (size_t)(t + 2) * kstep;
            const char* a3 = a2 + kstep; const char* b3 = b2 + kstep;
            if (last && has_next) S.a_ready(nxt);
            if constexpr (SP2) {
            PG8_LDB(B0, 0, 0); PG8_LDB(B1, 0, 1); PG8_SCHED; PG8_LDA(At, 0, 0); PG8_STAGE(PG8_SA(1, 1), a1 + hstep, voffA);
            PG8_WAIT_V(8); PG8_WAIT_L(0); PG8_BAR; PG8_MMA(0, 0, At, B0); PG8_MMA(0, 1, At, B1); PG8_BAR; PG8_SCHED;
            PG8_LDA(At, 0, 1); PG8_STAGE(PG8_SB(0, 0), b2, voffB); PG8_STAGE(PG8_SB(0, 1), b2 + hstep, voffB); PG8_STAGE(PG8_SA(0, 0), a2, voffA);
            PG8_WAIT_V(8); PG8_WAIT_L(0); PG8_BAR; PG8_MMA(1, 0, At, B0); PG8_MMA(1, 1, At, B1); PG8_BAR; PG8_SCHED;
            PG8_LDB(B0, 1, 0); PG8_LDB(B1, 1, 1); PG8_SCHED; PG8_LDA(At, 1, 0); PG8_STAGE(PG8_SA(0, 1), a2 + hstep, voffA);
            PG8_WAIT_V(8); PG8_WAIT_L(0); PG8_BAR; PG8_MMA(0, 0, At, B0); PG8_MMA(0, 1, At, B1); PG8_BAR; PG8_SCHED;
            PG8_LDA(At, 1, 1); PG8_STAGE(PG8_SB(1, 0), b3, voffB); PG8_STAGE(PG8_SB(1, 1), b3 + hstep, voffB); PG8_STAGE(PG8_SA(1, 0), a3, voffA);
            PG8_WAIT_V(8); PG8_WAIT_L(0); PG8_BAR; PG8_MMA(1, 0, At, B0); PG8_MMA(1, 1, At, B1); PG8_BAR; PG8_SCHED;
            } else {
            PG8_LDB(B0, 0, 0); PG8_SCHED; PG8_LDA(At, 0, 0); PG8_STAGE(PG8_SA(1, 1), a1 + hstep, voffA);
            PG8_WAIT_L(8); PG8_BAR; PG8_WAIT_L(0); PG8_MMA(0, 0, At, B0); PG8_BAR; PG8_SCHED;
            PG8_LDB(B1, 0, 1); PG8_STAGE(PG8_SB(0, 0), b2, voffB);
            PG8_BAR; PG8_WAIT_L(0); PG8_MMA(0, 1, At, B1); PG8_BAR;
            PG8_LDA(At, 0, 1); PG8_STAGE(PG8_SA(0, 0), a2, voffA);
            PG8_BAR; PG8_WAIT_L(0); PG8_MMA(1, 0, At, B0); PG8_BAR; PG8_SCHED;
            PG8_STAGE(PG8_SB(0, 1), b2 + hstep, voffB);
            PG8_WAIT_V(6); PG8_BAR; PG8_MMA(1, 1, At, B1); PG8_BAR;
            PG8_LDB(B0, 1, 0); PG8_SCHED; PG8_LDA(At, 1, 0); PG8_STAGE(PG8_SA(0, 1), a2 + hstep, voffA);
            PG8_WAIT_L(8); PG8_BAR; PG8_WAIT_L(0); PG8_MMA(0, 0, At, B0); PG8_BAR; PG8_SCHED;
            PG8_LDB(B1, 1, 1); PG8_STAGE(PG8_SB(1, 0), b3, voffB);
            PG8_BAR; PG8_WAIT_L(0); PG8_MMA(0, 1, At, B1); PG8_BAR;
            PG8_LDA(At, 1, 1); PG8_STAGE(PG8_SA(1, 0), a3, voffA);
            PG8_BAR; PG8_WAIT_L(0); PG8_MMA(1, 0, At, B0); PG8_BAR; PG8_SCHED;
            PG8_STAGE(PG8_SB(1, 1), b3 + hstep, voffB);
            PG8_WAIT_V(6); PG8_BAR; PG8_MMA(1, 1, At, B1); PG8_BAR;
            }
            if constexpr (Epi::MID) { if (t + 2 == Epi::MID_T0 || t + 2 == Epi::MID_T1) E.mid(acc, cur, (t + 2 == Epi::MID_T0) ? 0 : 1, wr, wc, fr, fq); }
        }
        if constexpr (ALIGN_EPI) { if (wr == 0) PG8_BAR; }
        if constexpr (!Epi::AFTER_DRAIN) { E(acc, cur, wr, wc, fr, fq); S.done(cur); }
        if (!has_next) break;
#pragma unroll
        for (int a = 0; a < 2; ++a)
#pragma unroll
            for (int b = 0; b < 2; ++b)
#pragma unroll
                for (int m = 0; m < 4; ++m)
#pragma unroll
                    for (int n = 0; n < 2; ++n) acc[a][b][m][n] = (f32x4){0.f, 0.f, 0.f, 0.f};
        cur = nxt; cA = nA; cB = nB; ++ui;
        if constexpr (ALIGN_EPI) { if (wr == 1) PG8_BAR; }
    }
    PG8_WAIT_V(0);
    if constexpr (!ALIGN_EPI) { if (wr == 0) PG8_BAR; }
    PG8_BAR;
    if constexpr (Epi::AFTER_DRAIN) { E.fused(acc, cur, wr, wc, fr, fq, lds, wid, lane); S.done(cur); }
#undef PG8_SA
#undef PG8_SB
#undef PG8_STAGE
#undef PG8_LDA
#undef PG8_LDB
#undef PG8_MMA
#undef PG8_WAIT_V
#undef PG8_WAIT_L
#undef PG8_BAR
#undef PG8_SCHED
}
}

#define XB_TMO      128
#define XB_XCNT(j)  (256  + 64 * (j))
#define XB_XSUB(j)  (1280 + 64 * (j))
#define XB_XGEN(j)  (2304 + 64 * (j))
#define XB_TOP      3328
#define XB_TOPGEN   3392
#define XCD_BAR_WORDS 3456
#define XB_SPIN_CAP (1u << 18)
__device__ __forceinline__ unsigned xb_ld(unsigned* p)              { return __hip_atomic_load(p, __ATOMIC_RELAXED, __HIP_MEMORY_SCOPE_AGENT); }
__device__ __forceinline__ unsigned xb_add(unsigned* p, unsigned v) { return __hip_atomic_fetch_add(p, v, __ATOMIC_RELAXED, __HIP_MEMORY_SCOPE_AGENT); }
__device__ __forceinline__ unsigned xb_xcc_id() { return (unsigned)__builtin_amdgcn_s_getreg((3 << 11) | 20) & 0xFu; }
#define XB_SPIN(cond, bar) do { unsigned _sp = 0; while (cond) { __builtin_amdgcn_s_sleep(1); \
    if ((++_sp & 255u) == 0u) { if (xb_ld(&(bar)[XB_TMO])) break; if (_sp > XB_SPIN_CAP) { atomicAdd(&(bar)[XB_TMO], 1u); break; } } } } while (0)
struct XcdBarrier { unsigned* bar; unsigned x; volatile LAS unsigned* st; };
__device__ __forceinline__ XcdBarrier xcd_barrier_post(unsigned* bar, volatile LAS unsigned* st) {
    XcdBarrier b; b.bar = bar; b.x = xb_xcc_id(); b.st = st;
    if (threadIdx.x == 0) (void)xb_add(&bar[XB_XCNT(b.x)], 1u);
    return b;
}
__device__ __forceinline__ void xcd_barrier_complete(unsigned* bar, unsigned x, unsigned& nloc, unsigned& nx) {
    const unsigned G = gridDim.x * gridDim.y * gridDim.z;
    unsigned sum, cnt, mine, sp = 0u;
    for (;;) {
        sum = 0u; cnt = 0u; mine = 0u;
#pragma unroll
        for (unsigned j = 0; j < 16; ++j) { const unsigned c = xb_ld(&bar[XB_XCNT(j)]); sum += c; cnt += (c > 0u) ? 1u : 0u; mine = (j == x) ? c : mine; }
        if (sum == G) break;
        __builtin_amdgcn_s_sleep(1);
        if ((++sp & 255u) == 0u) { if (xb_ld(&bar[XB_TMO])) break; if (sp > XB_SPIN_CAP) { atomicAdd(&bar[XB_TMO], 1u); break; } }
    }
    nloc = mine > 0u ? mine : 1u; nx = cnt > 0u ? cnt : 1u;
}
__device__ __forceinline__ void xcd_barrier(const XcdBarrier& b) {
    asm volatile("s_waitcnt vmcnt(0)" ::: "memory");
    __syncthreads();
    if (threadIdx.x == 0) {
        unsigned* bar = b.bar;
        __builtin_amdgcn_s_waitcnt(0);
        unsigned nloc = b.st[0], nx = b.st[1];
        if (nloc == 0u) { xcd_barrier_complete(bar, b.x, nloc, nx); b.st[0] = nloc; b.st[1] = nx; }
        const unsigned old = xb_add(&bar[XB_XSUB(b.x)], 1u);
        const unsigned gen = old / nloc;
        if (old + 1u == (gen + 1u) * nloc) {
            __builtin_amdgcn_fence(__ATOMIC_RELEASE, "agent");
            asm volatile("s_waitcnt vmcnt(0)" ::: "memory");
            const unsigned og = xb_add(&bar[XB_TOP], 1u);
            const unsigned tg = og / nx;
            if (og + 1u == (tg + 1u) * nx) xb_add(&bar[XB_TOPGEN], 1u);
            else XB_SPIN(xb_ld(&bar[XB_TOPGEN]) == tg, bar);
            __builtin_amdgcn_fence(__ATOMIC_ACQUIRE, "agent");
            xb_add(&bar[XB_XGEN(b.x)], 1u);
            asm volatile("s_waitcnt vmcnt(0)" ::: "memory");
        } else {
            XB_SPIN(xb_ld(&bar[XB_XGEN(b.x)]) == gen, bar);
            __builtin_amdgcn_fence(__ATOMIC_ACQUIRE, "agent");
            asm volatile("s_waitcnt vmcnt(0)" ::: "memory");
        }
    }
    __syncthreads();
}

struct P {
    const float *x_prompt, *x_sample, *c, *cache_k, *cache_v, *state_fwd, *state_bwd, *c_ctx, *norm_w, *w_ada, *b_ada, *w_in, *conv_w, *q_norm_w, *k_norm_w, *rpb,
                *w_alpha, *b_alpha, *gla_norm_w, *w_branch, *w_gate, *b_gate, *w_out;
    float* out; unsigned char* ws;
};
__device__ __forceinline__ float wave_sum(float v) {
#pragma unroll
    for (int o = 1; o < 64; o <<= 1) v += __shfl_xor(v, o);
    return v;
}

__device__ __forceinline__ void cvt_item(const float* W, int Nsrc, int k0, int srccol, bf16* dst, int Kdst, LAS float* scr, int lane) {
#pragma unroll 8
    for (int i = 0; i < 32; ++i) { const int kk = 2 * i + (lane >> 5); scr[kk * 33 + (lane & 31)] = srccol >= 0 ? W[(size_t)(k0 + kk) * Nsrc + srccol] : 0.f; }
    LDS_WAIT(); asm volatile("" ::: "memory");
    const int c = lane & 7;
#pragma unroll
    for (int j = 0; j < 4; ++j) { const int n = (lane >> 3) + 8 * j; const LAS float* s = scr + (8 * c) * 33 + n;
        v4u o; o.x = pk2(s[0 * 33], s[1 * 33]); o.y = pk2(s[2 * 33], s[3 * 33]); o.z = pk2(s[4 * 33], s[5 * 33]); o.w = pk2(s[6 * 33], s[7 * 33]);
        *(GAS v4u*)(dst + (size_t)n * Kdst + 8 * c) = o; }
    LDS_WAIT(); asm volatile("" ::: "memory");
}
constexpr int CV1 = 16 * (N1 / 32), CV2 = 3 * 8 * 32, CV3 = 16 * 32, CVL = CV1 + CV2 + CV3;
__device__ __forceinline__ void p0a(const P& p, LAS unsigned char* lds, int tid, int lane, int wave) {
    bf16* WB1 = (bf16*)(p.ws + WS_WB1); bf16* WB2 = (bf16*)(p.ws + WS_WB2); bf16* WB3 = (bf16*)(p.ws + WS_WB3);
    LAS float* scr = (LAS float*)(lds + wave * 8448);
    LAS float* SC = (LAS float*)(lds + 69632);
    for (int idx = tid; idx < NMOD * DM; idx += 512) { const int i = idx >> 10, k = idx & 1023; const float v = i == 0 ? p.c_ctx[k] : p.c[(i - 1) * DM + k]; SC[idx] = fsilu(v); }
    __syncthreads();
    const int gw = blockIdx.x * 8 + wave, NGW = gridDim.x * 8;
    for (int it = gw; it < DEPTH * 8 * 48; it += NGW) { const int nc = it % 48, ks = (it / 48) & 7, l = it / 384;
        float a[NMOD];
#pragma unroll
        for (int i = 0; i < NMOD; ++i) a[i] = 0.f;
        const float* W = p.w_ada + ((size_t)l * DM + 128 * ks) * 3072 + 64 * nc + lane;
#pragma unroll 4
        for (int k = 0; k < 128; ++k) { const float w = W[(size_t)k * 3072];
#pragma unroll
            for (int i = 0; i < NMOD; ++i) a[i] += w * SC[i * DM + 128 * ks + k]; }
        float* o = (float*)(p.ws + WS_MODP) + ((size_t)(l * 8 + ks) * NMOD) * 3072 + 64 * nc + lane;
#pragma unroll
        for (int i = 0; i < NMOD; ++i) o[(size_t)i * 3072] = a[i]; }
    for (int it = gw; it < DEPTH * CVL; it += NGW) { const int l = it / CVL; int r = it % CVL;
        if (r < CV1) { const int kb = r / (N1 / 32), nb = r % (N1 / 32); int mat, col; wb1_src(32 * nb + (lane & 31), mat, col);
            const int umat = __builtin_amdgcn_readfirstlane(mat);
            const float* W = umat == 1 ? p.w_gate + (size_t)l * DM * 3072 : p.w_in + (size_t)l * DM * 5664;
            cvt_item(W, umat == 1 ? 3072 : 5664, 64 * kb, umat < 0 ? -1 : col, WB1 + ((size_t)l * N1 + 32 * nb) * DM + 64 * kb, DM, scr, lane); continue; }
        r -= CV1;
        if (r < CV2) { const int b = r >> 8, kb = (r >> 5) & 7, nb = r & 31; const int n = 32 * nb + (lane & 31);
            cvt_item(p.w_branch + ((size_t)(l * 3 + b) * 512) * DM, DM, 64 * kb, 256 * (n >> 8) + pcol_of_slot(n & 255), WB2 + ((size_t)l * DM + 32 * nb) * 1536 + 512 * b + 64 * kb, 1536, scr, lane); continue; }
        r -= CV2;
        { const int kb = r >> 5, nb = r & 31;
            cvt_item(p.w_out + (size_t)l * DM * DM, DM, 64 * kb, 32 * nb + (lane & 31), WB3 + ((size_t)l * DM + 32 * nb) * DM + 64 * kb, DM, scr, lane); } }
    { const size_t n8 = (size_t)NB_LAT * DEPTH * 8 * PAST * 64 / 8; const size_t gt = (size_t)blockIdx.x * 512 + tid, NT = (size_t)gridDim.x * 512;
        for (size_t i = gt; i < 2 * n8; i += NT) { const bool isv = i >= n8; const size_t j = isv ? i - n8 : i;
            const float* src = (isv ? p.cache_v : p.cache_k) + j * 8; const f32x4 a = *(const f32x4*)src, b = *(const f32x4*)(src + 4);
            v4u o; o.x = pk2(a[0], a[1]); o.y = pk2(a[2], a[3]); o.z = pk2(b[0], b[1]); o.w = pk2(b[2], b[3]);
            *(v4u*)((bf16*)(p.ws + (isv ? WS_CVB : WS_CKB)) + j * 8) = o; } }
}
__device__ __forceinline__ float mod_sum(const P& p, int l, int i, int n) {
    const float* mp = (const float*)(p.ws + WS_MODP) + ((size_t)(l * 8) * NMOD + i) * 3072 + n; float s = p.b_ada[l * 3072 + n];
#pragma unroll
    for (int ks = 0; ks < 8; ++ks) s += mp[(size_t)ks * NMOD * 3072];
    return s;
}
__device__ __forceinline__ void p0b(const P& p, LAS unsigned char* lds, int tid, int lane, int wave) {
    LAS float* SH = (LAS float*)lds;
    LAS float* WE = (LAS float*)(lds + 36864);
    const int lb = blockIdx.x & 3;
    for (int idx = tid; idx < NMOD * DM; idx += 512) { const int i = idx >> 10, k = idx & 1023;
        SH[idx] = mod_sum(p, lb, i, k); WE[idx] = p.norm_w[k] * (1.f + mod_sum(p, 0, i, DM + k)); }
    { float* WEFF = (float*)(p.ws + WS_WEFF); float* GATEM = (float*)(p.ws + WS_GATEM);
        const int gt = blockIdx.x * 512 + tid;
        if (gt < DEPTH * NMOD * DM) { const int l = gt / (NMOD * DM), i = (gt / DM) % NMOD, k = gt & 1023;
            WEFF[gt] = p.norm_w[l * DM + k] * (1.f + mod_sum(p, l, i, DM + k)); GATEM[gt] = mod_sum(p, l, i, 2 * DM + k); } }
    __syncthreads();
    { const bf16* WB1 = (const bf16*)(p.ws + WS_WB1) + (size_t)lb * N1 * DM; float* BV = (float*)(p.ws + WS_BIASV) + (size_t)lb * NMOD * N1;
        for (int n = (blockIdx.x >> 2) * 8 + wave; n < N1; n += (gridDim.x >> 2) * 8) {
            const v4u w0 = *(const v4u*)(WB1 + (size_t)n * DM + 8 * lane), w1 = *(const v4u*)(WB1 + (size_t)n * DM + 512 + 8 * lane);
            float wf[16] = {bflo(w0.x), bfhi(w0.x), bflo(w0.y), bfhi(w0.y), bflo(w0.z), bfhi(w0.z), bflo(w0.w), bfhi(w0.w), bflo(w1.x), bfhi(w1.x), bflo(w1.y), bfhi(w1.y), bflo(w1.z), bfhi(w1.z), bflo(w1.w), bfhi(w1.w)};
            int mat, col; wb1_src(n, mat, col);
#pragma unroll
            for (int i = 0; i < NMOD; ++i) { const LAS float* sh = SH + i * DM + 8 * lane; float a = 0.f;
#pragma unroll
                for (int e = 0; e < 8; ++e) a += wf[e] * sh[e] + wf[8 + e] * sh[512 + e];
                a = wave_sum(a);
                if (lane == 0) BV[(size_t)i * N1 + n] = a + (mat == 1 ? p.b_gate[lb * 3072 + col] : 0.f); } } }
    { bf16* AP = (bf16*)(p.ws + WS_AP); float* SSP = (float*)(p.ws + WS_SSP);
        for (int R = blockIdx.x * 8 + wave; R < MROWS; R += gridDim.x * 8) {
            const float* xr = R < M_CTX ? p.x_prompt + (size_t)R * DM : p.x_sample + (size_t)(R - M_CTX) * DM; const int bi = R < M_CTX ? 0 : 1 + (R - M_CTX) / T_LAT;
            f32x4 v[4]; float ss = 0.f;
#pragma unroll
            for (int j = 0; j < 4; ++j) { v[j] = *(const f32x4*)(xr + 4 * lane + 256 * j); ss += (v[j][0] * v[j][0] + v[j][1] * v[j][1]) + (v[j][2] * v[j][2] + v[j][3] * v[j][3]); }
            ss = wave_sum(ss);
#pragma unroll
            for (int j = 0; j < 4; ++j) { const f32x4 w = *(const LAS f32x4*)(WE + bi * DM + 4 * lane + 256 * j); const f32x4 a = v[j] * w;
                v2u o; o.x = pk2(a[0], a[1]); o.y = pk2(a[2], a[3]); *(v2u*)(AP + (size_t)R * DM + 4 * lane + 256 * j) = o; }
            if (lane < 16) SSP[(size_t)R * 16 + lane] = lane == 0 ? ss : 0.f; } }
}

__device__ __forceinline__ int crow(int r, int hi) { return (r & 3) + 8 * (r >> 2) + 4 * hi; }
__device__ __forceinline__ f32x16 mfma32(bf16x8 a, bf16x8 b, f32x16 c) { return __builtin_amdgcn_mfma_f32_32x32x16_bf16(a, b, c, 0, 0, 0); }
typedef short v4i16_t __attribute__((ext_vector_type(4)));
__device__ __forceinline__ s16x4 ldtr(const LAS unsigned char* p) { return __builtin_bit_cast(s16x4, __builtin_amdgcn_ds_read_tr16_b64_v4i16((LAS v4i16_t*)p)); }
__device__ __forceinline__ bf16x8 cat8(s16x4 lo, s16x4 hi) { return (bf16x8){lo[0], lo[1], lo[2], lo[3], hi[0], hi[1], hi[2], hi[3]}; }
typedef float f32x2_t __attribute__((ext_vector_type(2))); typedef __bf16 bf16x2_t __attribute__((ext_vector_type(2)));
__device__ __forceinline__ unsigned cvtpk(float lo, float hi) { f32x2_t v = {lo, hi}; bf16x2_t b = __builtin_convertvector(v, bf16x2_t); return __builtin_bit_cast(unsigned, b); }
__device__ __forceinline__ bf16x8 accfrag(const f32x16& x, int s) {
    v4u w; const int b = 8 * s;
    w.x = cvtpk(x[b + 0], x[b + 1]); w.y = cvtpk(x[b + 2], x[b + 3]); w.z = cvtpk(x[b + 4], x[b + 5]); w.w = cvtpk(x[b + 6], x[b + 7]);
    return __builtin_bit_cast(bf16x8, w);
}

__device__ __forceinline__ void conv_unit(const P& p, int layer, int unit, int tid) {
    const bf16* CI = (const bf16*)(p.ws + WS_CONVIN); bf16* Y = (bf16*)(p.ws + WS_Y);
    const int cl = tid & 63, tg = tid >> 6, c0 = 8 * cl;
    const int row0 = unit * 64 + 8 * tg;
    const int T = row0 < M_CTX ? T_CTX : T_LAT; const int tin = (row0 < M_CTX ? row0 : row0 - M_CTX) % T;
    float w[3][8];
#pragma unroll
    for (int k = 0; k < 3; ++k) { const f32x4 a = *(const f32x4*)(p.conv_w + ((size_t)layer * 3 + k) * 512 + c0), b = *(const f32x4*)(p.conv_w + ((size_t)layer * 3 + k) * 512 + c0 + 4);
#pragma unroll
        for (int e = 0; e < 4; ++e) { w[k][e] = a[e]; w[k][4 + e] = b[e]; } }
    float up[8], uc[8], un[8];
    auto LD8 = [](const bf16* q, float (&o)[8]) { const v4u v = *(const v4u*)q; o[0] = bflo(v.x); o[1] = bfhi(v.x); o[2] = bflo(v.y); o[3] = bfhi(v.y); o[4] = bflo(v.z); o[5] = bfhi(v.z); o[6] = bflo(v.w); o[7] = bfhi(v.w); };
    auto U = [&](int row, bool valid, float (&o)[8]) { if (valid) { float xa[8], ca[8]; LD8(CI + (size_t)row * 2048 + c0, xa); LD8(CI + (size_t)row * 2048 + 1024 + c0, ca);
#pragma unroll
            for (int e = 0; e < 8; ++e) o[e] = xa[e] * ca[e]; } else {
#pragma unroll
            for (int e = 0; e < 8; ++e) o[e] = 0.f; } };
    U(row0 - 1, tin > 0, up); U(row0, true, uc);
#pragma unroll
    for (int i = 0; i < 8; ++i) { const int row = row0 + i; U(row + 1, tin + i + 1 < T, un);
        float ba[8], sg[8]; LD8(CI + (size_t)row * 2048 + 512 + c0, ba); LD8(CI + (size_t)row * 2048 + 1536 + c0, sg);
        float y[8];
#pragma unroll
        for (int e = 0; e < 8; ++e) y[e] = ba[e] * (w[0][e] * up[e] + w[1][e] * uc[e] + w[2][e] * un[e]) * sg[e];
        v4u o; o.x = pk2(y[0], y[1]); o.y = pk2(y[2], y[3]); o.z = pk2(y[4], y[5]); o.w = pk2(y[6], y[7]);
        *(v4u*)(Y + (size_t)row * 1536 + c0) = o;
#pragma unroll
        for (int e = 0; e < 8; ++e) { up[e] = uc[e]; uc[e] = un[e]; } }
}

constexpr int NA_K = 0, NA_V = 16384, NA_TAB = 32768;
__device__ __forceinline__ int na_koff(int key, int chunk) { return key * 128 + ((chunk ^ ((key >> 1) & 7)) << 4); }
__device__ __forceinline__ int na_voff(int key, int chunk) { return key * 128 + ((chunk ^ (((key >> 1) & 1) << 2)) << 4); }
template <bool LAT>
__device__ __forceinline__ void na_unit(const P& p, LAS unsigned char* lds, int layer, int b, int h, int R4, int tid, int lane, int wave) {
    const bf16* NA = (const bf16*)(p.ws + WS_NA); bf16* Y = (bf16*)(p.ws + WS_Y);
    const int r32 = lane & 31, hh = lane >> 5;
    int grow = 0, chalf = 0, qrow;
    if (LAT) { grow = 4 * R4 + (wave >> 1); chalf = wave & 1; qrow = M_CTX + b * T_LAT + 64 * grow + 32 * chalf + r32; } else qrow = b * T_CTX + 32 * wave + r32;
    bf16x8 qf[4];
#pragma unroll
    for (int kk = 0; kk < 4; ++kk) qf[kk] = *(const bf16x8*)(NA + (size_t)qrow * 2048 + 64 * h + 16 * kk + 8 * hh);
    int ntile = 4, nwin = 0, kr0 = 0, myrs = 0;
    if (LAT) { const int lo = min(max(4 * R4 - 4, 0), 24), hi = min(max(4 * R4 + 3 - 4, 0), 24); kr0 = lo; nwin = hi + 8 - lo; ntile = nwin + 8; myrs = min(max(grow - 4, 0), 24); }
    LAS float* tab = (LAS float*)(lds + NA_TAB);
    if (LAT) { for (int i = tid; i < 15 * 128; i += 512) { const int dr = i >> 7, dc = (i & 127) - 48; tab[i] = (dc >= 0 && dc < 31) ? p.rpb[(((size_t)layer * 8 + h) * 15 + dr) * 31 + dc] * LOG2E : 0.f; } }
    const int skey = tid >> 3, sch = tid & 7;
    const bf16* CKB = (const bf16*)(p.ws + WS_CKB); const bf16* CVB = (const bf16*)(p.ws + WS_CVB);
#define NA_SRC(i, kp, vp) do { if (!LAT) { const size_t row = (size_t)(b * T_CTX + 64 * (i) + skey); kp = NA + row * 2048 + 512 + 64 * h + 8 * sch; vp = kp + 512; } \
        else if ((i) < nwin) { const size_t row = (size_t)(M_CTX + b * T_LAT + 64 * (kr0 + (i)) + skey); kp = NA + row * 2048 + 512 + 64 * h + 8 * sch; vp = kp + 512; } \
        else { const size_t idx = ((((size_t)b * DEPTH + layer) * 8 + h) * PAST + 64 * ((i) - nwin) + skey) * 64 + 8 * sch; kp = CKB + idx; vp = CVB + idx; } } while (0)
    v4u kreg, vreg;
    { const bf16 *kp, *vp; NA_SRC(0, kp, vp); kreg = *(const v4u*)kp; vreg = *(const v4u*)vp; }
    *(LAS v4u*)(lds + NA_K + na_koff(skey, sch)) = kreg; *(LAS v4u*)(lds + NA_V + na_voff(skey, sch)) = vreg;
    __syncthreads();
    const float C = 0.125f * LOG2E;
    const int qc = 32 * chalf + r32, cs = min(max(qc - 8, 0), 48);
    float m_run = -1e30f, l_run = 0.f; f32x16 o0 = {0}, o1 = {0};
    const int tq = (lane & 15) >> 2, tp = lane & 3, tg = (lane >> 4) & 1;
#pragma nounroll
    for (int i = 0; i < ntile; ++i) {
        const int buf = i & 1;
        if (i + 1 < ntile) { const bf16 *kp, *vp; NA_SRC(i + 1, kp, vp); kreg = *(const v4u*)kp; vreg = *(const v4u*)vp; }
        bool active = true; int dr = 0;
        if (LAT && i < nwin) { const int kr = kr0 + i; active = (kr >= myrs) && (kr < myrs + 8); dr = kr - grow; }
        if (__builtin_amdgcn_readfirstlane((int)active)) {
            const LAS unsigned char* Kb = lds + NA_K + buf * 8192; const LAS unsigned char* Vb = lds + NA_V + buf * 8192;
            f32x16 s0 = {0}, s1 = {0};
#pragma unroll
            for (int kk = 0; kk < 4; ++kk) { const bf16x8 ka = *(const LAS bf16x8*)(Kb + na_koff(r32, 2 * kk + hh)), kb = *(const LAS bf16x8*)(Kb + na_koff(32 + r32, 2 * kk + hh));
                s0 = mfma32(ka, qf[kk], s0); s1 = mfma32(kb, qf[kk], s1); }
            if (LAT && i < nwin) { const LAS float* tb = tab + (dr + 7) * 128 + (4 * hh - qc + 15 + 48);
                const int klo = cs - 4 * hh;
#pragma unroll
                for (int r = 0; r < 16; ++r) { const int k0 = (r & 3) + 8 * (r >> 2); const float b0 = tb[k0], b1 = tb[k0 + 32];
                    const float v0 = __builtin_fmaf(s0[r], C, b0), v1 = __builtin_fmaf(s1[r], C, b1);
                    s0[r] = (unsigned)(k0 - klo) < 16u ? v0 : -1e30f; s1[r] = (unsigned)(k0 + 32 - klo) < 16u ? v1 : -1e30f; }
            } else { s0 = s0 * C; s1 = s1 * C; }
            float mt = __builtin_fmaxf(s0[0], s1[0]);
#pragma unroll
            for (int r = 1; r < 16; ++r) mt = __builtin_fmaxf(mt, __builtin_fmaxf(s0[r], s1[r]));
            mt = __builtin_fmaxf(mt, __shfl_xor(mt, 32));
            const float mn = __builtin_fmaxf(m_run, mt), alpha = __builtin_amdgcn_exp2f(m_run - mn); m_run = mn;
            float ps = 0.f;
#pragma unroll
            for (int r = 0; r < 16; ++r) { s0[r] = __builtin_amdgcn_exp2f(s0[r] - mn); s1[r] = __builtin_amdgcn_exp2f(s1[r] - mn); ps += s0[r] + s1[r]; }
            l_run = l_run * alpha + ps;
            if (__any(alpha != 1.f)) { o0 = o0 * alpha; o1 = o1 * alpha; }
            const bf16x8 pf00 = accfrag(s0, 0), pf01 = accfrag(s0, 1), pf10 = accfrag(s1, 0), pf11 = accfrag(s1, 1);
#pragma unroll
            for (int dt = 0; dt < 2; ++dt) {
#pragma unroll
                for (int ks = 0; ks < 4; ++ks) {
                    const int r0 = 16 * ks + 4 * hh + tq, chunk = 4 * dt + 2 * tg + (tp >> 1);
                    const s16x4 lo = ldtr(Vb + na_voff(r0, chunk) + 8 * (tp & 1)), hi = ldtr(Vb + na_voff(r0 + 8, chunk) + 8 * (tp & 1));
                    const bf16x8 va = cat8(lo, hi); const bf16x8 pf = ks == 0 ? pf00 : ks == 1 ? pf01 : ks == 2 ? pf10 : pf11;
                    if (dt == 0) o0 = mfma32(va, pf, o0); else o1 = mfma32(va, pf, o1); } }
        }
        if (i + 1 < ntile) { *(LAS v4u*)(lds + NA_K + (buf ^ 1) * 8192 + na_koff(skey, sch)) = kreg; *(LAS v4u*)(lds + NA_V + (buf ^ 1) * 8192 + na_voff(skey, sch)) = vreg; }
        __syncthreads();
    }
#undef NA_SRC
    const float inv = __builtin_amdgcn_rcpf(l_run + __shfl_xor(l_run, 32));
#pragma unroll
    for (int dt = 0; dt < 2; ++dt)
#pragma unroll
        for (int g4 = 0; g4 < 4; ++g4) { const int d0 = 32 * dt + 8 * g4 + 4 * hh; const f32x16& o = dt == 0 ? o0 : o1;
            const v2u gt = *(const v2u*)(NA + (size_t)qrow * 2048 + 1536 + 64 * h + d0);
            v2u w; w.x = cvtpk(o[4 * g4 + 0] * inv * bflo(gt.x), o[4 * g4 + 1] * inv * bfhi(gt.x)); w.y = cvtpk(o[4 * g4 + 2] * inv * bflo(gt.y), o[4 * g4 + 3] * inv * bfhi(gt.y));
            *(v2u*)(Y + (size_t)qrow * 1536 + 512 + 64 * h + d0) = w; }
}

constexpr int GL_STRIDE = 136;
constexpr int GL_LQ = 0, GL_LK = 8704, GL_LKT = 17408, GL_LV = 26112, GL_DV = 42496, GL_BUF = 42752;
constexpr int GL_WA = 2 * GL_BUF, GL_BA = GL_WA + 4096;
template <int CTRL, int RM> __device__ __forceinline__ float dppf(float v) { return __builtin_bit_cast(float, __builtin_amdgcn_update_dpp(0, __builtin_bit_cast(int, v), CTRL, RM, 0xf, false)); }
__device__ __forceinline__ float wave_scan_incl(float v) {
    v += dppf<0x111, 0xf>(v); v += dppf<0x112, 0xf>(v); v += dppf<0x114, 0xf>(v); v += dppf<0x118, 0xf>(v);
    v += dppf<0x142, 0xa>(v); v += dppf<0x143, 0xc>(v);
    return v;
}
__device__ __forceinline__ bf16x8 ld2x8(const LAS unsigned char* p) { const s16x4 lo = *(const LAS s16x4*)p, hi = *(const LAS s16x4*)(p + 16); return cat8(lo, hi); }
struct GlaRaw { f32x4 l4[4]; v4u q0, q1, k0, k1, v[4]; };
__device__ __forceinline__ void gla_task(const P& p, LAS unsigned char* lds, int layer, bool lat, int b, int h, int dir, int tid, int lane, int wave) {
    const bf16* G = (const bf16*)(p.ws + WS_G); const float* LR = (const float*)(p.ws + WS_LR);
    bf16* OG = (bf16*)(p.ws + WS_OGLA) + (size_t)dir * MROWS * 512;
    const int gw = wave & 3, r32 = lane & 31, hh = lane >> 5;
    const bool producer = wave >= 4;
    const int T = lat ? T_LAT : T_CTX, nch = T / 64, seqbase = lat ? M_CTX + b * T_LAT : b * T_CTX;
    LAS float* WA = (LAS float*)(lds + GL_WA); LAS float* BA = (LAS float*)(lds + GL_BA);
    for (int i = tid; i < 16 * 64; i += 512) { const int r = i >> 6, kd = i & 63; WA[i] = p.w_alpha[(((size_t)layer * 2 + dir) * 16 + r) * 256 + 64 * h + kd]; }
    if (tid < 64) BA[tid] = p.b_alpha[((size_t)layer * 2 + dir) * 256 + 64 * h + tid];
    __syncthreads();
#define GLA_ROW(c) ((size_t)(seqbase + (dir ? T - 1 - (64 * (c) + lane) : 64 * (c) + lane)))
#define GLA_LOAD(R, c) do { const size_t row_ = GLA_ROW(c); const float* lp_ = LR + row_ * 32 + 16 * dir; const bf16* gp_ = G + row_ * 1536 + 64 * h + 16 * gw; \
        _Pragma("unroll") for (int j_ = 0; j_ < 4; ++j_) R.l4[j_] = *(const f32x4*)(lp_ + 4 * j_); \
        R.q0 = *(const v4u*)gp_; R.q1 = *(const v4u*)(gp_ + 8); R.k0 = *(const v4u*)(gp_ + 256); R.k1 = *(const v4u*)(gp_ + 264); \
        const bf16* vp_ = G + row_ * 1536 + 512 + 128 * h + 32 * gw; _Pragma("unroll") for (int j_ = 0; j_ < 4; ++j_) R.v[j_] = *(const v4u*)(vp_ + 8 * j_); } while (0)
    if (producer) {
        GlaRaw R; GLA_LOAD(R, 0);
#pragma nounroll
        for (int c = 0; c < nch; ++c) {
            LAS unsigned char* D = lds + (c & 1) * GL_BUF;
            float bc[16];
#pragma unroll
            for (int e = 0; e < 16; ++e) { float z = BA[16 * gw + e];
#pragma unroll
                for (int r = 0; r < 16; ++r) z += R.l4[r >> 2][r & 3] * WA[r * 64 + 16 * gw + e];
                const float ls = __builtin_fminf(z, 0.f) - __logf(1.f + __expf(-__builtin_fabsf(z)));
                bc[e] = wave_scan_incl(ls * 0.0625f); }
            const unsigned qw[8] = {R.q0.x, R.q0.y, R.q0.z, R.q0.w, R.q1.x, R.q1.y, R.q1.z, R.q1.w}, kw[8] = {R.k0.x, R.k0.y, R.k0.z, R.k0.w, R.k1.x, R.k1.y, R.k1.z, R.k1.w};
            unsigned qo[8], ko[8];
#pragma unroll
            for (int e2 = 0; e2 < 8; ++e2) { const float b0 = bc[2 * e2], b1 = bc[2 * e2 + 1];
                const float bl0 = __builtin_bit_cast(float, __builtin_amdgcn_readlane(__builtin_bit_cast(int, b0), 63)), bl1 = __builtin_bit_cast(float, __builtin_amdgcn_readlane(__builtin_bit_cast(int, b1), 63));
                const float eq0 = __expf(b0), eq1 = __expf(b1), ek0 = __expf(-b0), ek1 = __expf(-b1), el0 = __expf(bl0 - b0), el1 = __expf(bl1 - b1);
                const float kx = bflo(kw[e2]), ky = bfhi(kw[e2]);
                qo[e2] = cvtpk(bflo(qw[e2]) * eq0, bfhi(qw[e2]) * eq1); ko[e2] = cvtpk(kx * ek0, ky * ek1);
                const unsigned kt = cvtpk(kx * el0, ky * el1);
                *(LAS unsigned short*)(D + GL_LKT + (16 * gw + 2 * e2) * GL_STRIDE + 2 * lane) = (unsigned short)(kt & 0xffffu);
                *(LAS unsigned short*)(D + GL_LKT + (16 * gw + 2 * e2 + 1) * GL_STRIDE + 2 * lane) = (unsigned short)(kt >> 16);
                if (lane == 63) { ((LAS float*)(D + GL_DV))[16 * gw + 2 * e2] = __expf(bl0); ((LAS float*)(D + GL_DV))[16 * gw + 2 * e2 + 1] = __expf(bl1); } }
#pragma unroll
            for (int j = 0; j < 4; ++j) { *(LAS v2u*)(D + GL_LQ + lane * GL_STRIDE + 32 * gw + 8 * j) = (v2u){qo[2 * j], qo[2 * j + 1]}; *(LAS v2u*)(D + GL_LK + lane * GL_STRIDE + 32 * gw + 8 * j) = (v2u){ko[2 * j], ko[2 * j + 1]}; }
#pragma unroll
            for (int j = 0; j < 4; ++j) *(LAS v4u*)(D + GL_LV + lane * 256 + ((gw ^ (lane & 3)) << 6) + 16 * j) = R.v[j];
            if (c + 1 < nch) GLA_LOAD(R, c + 1);
            __syncthreads();
        }
        __syncthreads();
    } else {
        f32x16 S0 = {0}, S1 = {0};
        if (lat) { const float* st = (dir ? p.state_bwd : p.state_fwd) + (((size_t)b * DEPTH + layer) * 4 + h) * 64 * 128 + 32 * gw + r32;
#pragma unroll
            for (int r = 0; r < 16; ++r) { S0[r] = st[(size_t)crow(r, hh) * 128]; S1[r] = st[(size_t)(32 + crow(r, hh)) * 128]; } }
        const int tq = (lane & 15) >> 2, tp = lane & 3, tg = (lane >> 4) & 1;
        __syncthreads();
#pragma nounroll
        for (int c = 0; c < nch; ++c) {
            const LAS unsigned char* D = lds + (c & 1) * GL_BUF;
            f32x16 oA, oB;
            {
                bf16x8 Qf[2][4];
#pragma unroll
                for (int ti = 0; ti < 2; ++ti)
#pragma unroll
                    for (int ks = 0; ks < 4; ++ks) Qf[ti][ks] = ld2x8(D + GL_LQ + (32 * ti + r32) * GL_STRIDE + (16 * ks + 4 * hh) * 2);
                bf16x8 AF[6];
                {
                    f32x16 a00 = {0}, a01 = {0}, a11 = {0};
#pragma unroll
                    for (int ks = 0; ks < 4; ++ks) { const bf16x8 k0 = ld2x8(D + GL_LK + r32 * GL_STRIDE + (16 * ks + 4 * hh) * 2), k1 = ld2x8(D + GL_LK + (32 + r32) * GL_STRIDE + (16 * ks + 4 * hh) * 2);
                        a00 = mfma32(k0, Qf[0][ks], a00); a01 = mfma32(k0, Qf[1][ks], a01); a11 = mfma32(k1, Qf[1][ks], a11); }
#pragma unroll
                    for (int r = 0; r < 16; ++r) if (crow(r, hh) > r32) { a00[r] = 0.f; a11[r] = 0.f; }
                    AF[0] = accfrag(a00, 0); AF[1] = accfrag(a00, 1); AF[2] = accfrag(a01, 0); AF[3] = accfrag(a01, 1); AF[4] = accfrag(a11, 0); AF[5] = accfrag(a11, 1);
                }
                bf16x8 Vf[4];
#pragma unroll
                for (int k4 = 0; k4 < 4; ++k4) { const int r0 = 16 * k4 + 4 * hh + tq; const int cb = 32 * gw + 16 * tg + 4 * tp;
                    const int blk = cb >> 5, inner = (cb & 31) * 2;
                    const s16x4 lo = ldtr(D + GL_LV + r0 * 256 + ((blk ^ (r0 & 3)) << 6) + inner), hi = ldtr(D + GL_LV + (r0 + 8) * 256 + ((blk ^ ((r0 + 8) & 3)) << 6) + inner);
                    Vf[k4] = cat8(lo, hi); }
                {
                    const bf16x8 Sf0 = accfrag(S0, 0), Sf1 = accfrag(S0, 1), Sf2 = accfrag(S1, 0), Sf3 = accfrag(S1, 1);
                    oA = mfma32(Sf0, Qf[0][0], (f32x16){0}); oA = mfma32(Sf1, Qf[0][1], oA); oA = mfma32(Sf2, Qf[0][2], oA); oA = mfma32(Sf3, Qf[0][3], oA);
                    oB = mfma32(Sf0, Qf[1][0], (f32x16){0}); oB = mfma32(Sf1, Qf[1][1], oB); oB = mfma32(Sf2, Qf[1][2], oB); oB = mfma32(Sf3, Qf[1][3], oB);
                }
                oA = mfma32(Vf[0], AF[0], oA); oA = mfma32(Vf[1], AF[1], oA);
                oB = mfma32(Vf[0], AF[2], oB); oB = mfma32(Vf[1], AF[3], oB); oB = mfma32(Vf[2], AF[4], oB); oB = mfma32(Vf[3], AF[5], oB);
                const LAS float* dv = (const LAS float*)(D + GL_DV);
#pragma unroll
                for (int g4 = 0; g4 < 4; ++g4) { const f32x4 d0 = *(const LAS f32x4*)(dv + 8 * g4 + 4 * hh), d1 = *(const LAS f32x4*)(dv + 32 + 8 * g4 + 4 * hh);
#pragma unroll
                    for (int e = 0; e < 4; ++e) { S0[4 * g4 + e] *= d0[e]; S1[4 * g4 + e] *= d1[e]; } }
#pragma unroll
                for (int k4 = 0; k4 < 4; ++k4) { const bf16x8 kt0 = ld2x8(D + GL_LKT + r32 * GL_STRIDE + (16 * k4 + 4 * hh) * 2), kt1 = ld2x8(D + GL_LKT + (32 + r32) * GL_STRIDE + (16 * k4 + 4 * hh) * 2);
                    S0 = mfma32(kt0, Vf[k4], S0); S1 = mfma32(kt1, Vf[k4], S1); }
            }
            const int tauA = 64 * c + r32; const size_t rowA = (size_t)(seqbase + (dir ? T - 1 - tauA : tauA)), rowB = (size_t)(seqbase + (dir ? T - 1 - (tauA + 32) : tauA + 32));
            bf16* yA = OG + rowA * 512 + 128 * h + 32 * gw + 4 * hh; bf16* yB = OG + rowB * 512 + 128 * h + 32 * gw + 4 * hh;
#pragma unroll
            for (int g4 = 0; g4 < 4; ++g4) { v2u wa, wb; wa.x = cvtpk(oA[4 * g4], oA[4 * g4 + 1]); wa.y = cvtpk(oA[4 * g4 + 2], oA[4 * g4 + 3]); wb.x = cvtpk(oB[4 * g4], oB[4 * g4 + 1]); wb.y = cvtpk(oB[4 * g4 + 2], oB[4 * g4 + 3]);
                *(v2u*)(yA + 8 * g4) = wa; *(v2u*)(yB + 8 * g4) = wb; }
            __syncthreads();
        }
        if (!lat) { float* so = p.out + (dir ? OUT_SB : OUT_SF) + (((size_t)b * DEPTH + layer) * 4 + h) * 64 * 128 + 32 * gw + r32;
#pragma unroll
            for (int r = 0; r < 16; ++r) { so[(size_t)crow(r, hh) * 128] = S0[r] * DBG_SCALE_ST; so[(size_t)(32 + crow(r, hh)) * 128] = S1[r] * DBG_SCALE_ST; } }
    }
#undef GLA_LOAD
#undef GLA_ROW
}
__device__ __forceinline__ void gla_combine(const P& p, int layer) {
    int tid_ = threadIdx.x; asm volatile("" : "+v"(tid_)); const int lane = tid_ & 63, wave = __builtin_amdgcn_readfirstlane(tid_ >> 6);
    const bf16* OF = (const bf16*)(p.ws + WS_OGLA); const bf16* OB = OF + (size_t)MROWS * 512; const bf16* G = (const bf16*)(p.ws + WS_G); bf16* Y = (bf16*)(p.ws + WS_Y);
    f32x4 nw0 = *(const f32x4*)(p.gla_norm_w + layer * 128 + 8 * (lane & 15)), nw1 = *(const f32x4*)(p.gla_norm_w + layer * 128 + 8 * (lane & 15) + 4);
    for (int R = blockIdx.x * 8 + wave; R < MROWS; R += gridDim.x * 8) {
        const v4u a = *(const v4u*)(OF + (size_t)R * 512 + 8 * lane), b = *(const v4u*)(OB + (size_t)R * 512 + 8 * lane), g = *(const v4u*)(G + (size_t)R * 1536 + 1024 + 8 * lane);
        float o[8] = {bflo(a.x) + bflo(b.x), bfhi(a.x) + bfhi(b.x), bflo(a.y) + bflo(b.y), bfhi(a.y) + bfhi(b.y), bflo(a.z) + bflo(b.z), bfhi(a.z) + bfhi(b.z), bflo(a.w) + bflo(b.w), bfhi(a.w) + bfhi(b.w)};
        float ss = 0.f;
#pragma unroll
        for (int e = 0; e < 8; ++e) ss += o[e] * o[e];
        ss += __shfl_xor(ss, 1); ss += __shfl_xor(ss, 2); ss += __shfl_xor(ss, 4); ss += __shfl_xor(ss, 8);
        const float rs = __builtin_amdgcn_rsqf(ss * (1.f / 128.f) + EPS);
        v4u w; w.x = cvtpk(o[0] * rs * nw0[0] * bflo(g.x), o[1] * rs * nw0[1] * bfhi(g.x)); w.y = cvtpk(o[2] * rs * nw0[2] * bflo(g.y), o[3] * rs * nw0[3] * bfhi(g.y));
        w.z = cvtpk(o[4] * rs * nw1[0] * bflo(g.z), o[5] * rs * nw1[1] * bfhi(g.z)); w.w = cvtpk(o[6] * rs * nw1[2] * bflo(g.w), o[7] * rs * nw1[3] * bfhi(g.w));
        *(v4u*)(Y + (size_t)R * 1536 + 1024 + 8 * lane) = w; }
}
#ifndef REP_P0
#define REP_P0 1
#endif
#ifndef REP_G1
#define REP_G1 1
#endif
#ifndef REP_MIX
#define REP_MIX 1
#endif
#ifndef REP_GG
#define REP_GG 1
#endif
#ifndef REP_G2
#define REP_G2 1
#endif
#ifndef MAXPH
#define MAXPH 999
#endif
#ifndef ZERO_OUT
#define ZERO_OUT 0
#endif
struct Args { P p; };
__global__ void __launch_bounds__(512, 2) fwd_kernel(Args args) {
    extern __shared__ __attribute__((aligned(16))) unsigned char lds_raw[];
    LAS unsigned char* lds = (LAS unsigned char*)lds_raw;
    const P& p = args.p;
    const int tid = threadIdx.x, lane = tid & 63, wave = __builtin_amdgcn_readfirstlane(tid >> 6);
    for (int u = tid; u < (LDS_BYTES - LDSCTL_OFF) / 4; u += 512) ((LAS unsigned*)(lds + LDSCTL_OFF))[u] = 0u;
    __syncthreads();
    gu32* ctl = (gu32*)(p.ws + WS_CTL);
    XcdBarrier bar = xcd_barrier_post((unsigned*)(ctl + CW_BAR), (volatile LAS unsigned*)(lds + MISC_OFF) + 8);
    const int G = gridDim.x;
    int nph = 0;
#define PHASE_END() do { xcd_barrier(bar); if (++nph > MAXPH) return; } while (0)
#if ZERO_OUT
    for (size_t i = (size_t)blockIdx.x * 512 + tid; i < OUT_TOTAL; i += (size_t)G * 512) p.out[i] = 0.f;
#endif
#pragma nounroll
    for (int rep = 0; rep < REP_P0; ++rep) {
#ifndef NO_P0
    p0a(p, lds, tid, lane, wave);
#endif
    PHASE_END();
#ifndef NO_P0
    p0b(p, lds, tid, lane, wave);
#endif
    PHASE_END();
    }
    bf16* AP = (bf16*)(p.ws + WS_AP); bf16* Yb = (bf16*)(p.ws + WS_Y); bf16* MG = (bf16*)(p.ws + WS_MERGED); bf16* GT = (bf16*)(p.ws + WS_GATES);
#pragma nounroll
    for (int l = 0; l < DEPTH; ++l) {
        const bf16* WB1 = (const bf16*)(p.ws + WS_WB1) + (size_t)l * N1 * DM;
        pg8::EpiG1 E1{l, 0, p.ws, p.out, p.q_norm_w + l * 64, p.k_norm_w + l * 64};
#pragma nounroll
        for (int rep = 0; rep < REP_G1; ++rep) {
        { pg8::Gemm g{AP, WB1, MROWS, TILE_GATE0 * 256, DM}; pg8::StaticOrder S; S.init(MROWS, TILE_GATE0 * 256, G, (int)blockIdx.x);
#ifndef NO_G1
          pg8::gemm_phase<pg8::EpiG1, pg8::StaticOrder, true, true>(lds, g, S, E1);
#endif
        }
        PHASE_END();
        }
#pragma nounroll
        for (int rep = 0; rep < REP_MIX; ++rep) {
        {
            const int bx = blockIdx.x;
#pragma nounroll
            for (int it = bx, st = bx < 64 ? 100000 : G - 64; it < 64 + 1088; it += st) {
                int tid_m = threadIdx.x; asm volatile("" : "+v"(tid_m));
                const int lane_m = tid_m & 63, wave_m = __builtin_amdgcn_readfirstlane(tid_m >> 6);
                const int j = it - 64;
                if (it < 64 || (j >= 512 && j < 640)) {
#ifndef NO_GLA
                    const bool lat = it < 64; const int q = lat ? it : j - 512;
                    gla_task(p, lds, l, lat, q >> 3, (q >> 1) & 3, q & 1, tid_m, lane_m, wave_m);
#endif
                } else if (j < 512) {
#ifndef NO_NA
                    na_unit<true>(p, lds, l, j >> 6, (j >> 3) & 7, j & 7, tid_m, lane_m, wave_m);
#endif
                } else if (j < 768) {
#ifndef NO_NA
                    const int q = j - 640; na_unit<false>(p, lds, l, q >> 3, q & 7, 0, tid_m, lane_m, wave_m);
#endif
                } else {
#ifndef NO_CONV
                    conv_unit(p, l, j - 768, tid_m);
#endif
                }
                __syncthreads();
            }
        }
        PHASE_END();
        }
#pragma nounroll
        for (int rep = 0; rep < REP_GG; ++rep) {
        gla_combine(p, l);
        { pg8::EpiG1 Eg = E1; Eg.tile0 = TILE_GATE0;
          pg8::Gemm g{AP, WB1 + (size_t)TILE_GATE0 * 256 * DM, MROWS, 12 * 256, DM}; pg8::StaticOrder S; S.init(MROWS, 12 * 256, G, (int)blockIdx.x);
#ifndef NO_GG
          pg8::gemm_phase<pg8::EpiG1, pg8::StaticOrder, true, true>(lds, g, S, Eg);
#endif
        }
        PHASE_END();
        }
#pragma nounroll
        for (int rep = 0; rep < REP_G2; ++rep) {
        { pg8::Gemm g{Yb, (const bf16*)(p.ws + WS_WB2) + (size_t)l * DM * 1536, MROWS, DM, 1536}; pg8::StaticOrder S; S.init(MROWS, DM, G, (int)blockIdx.x);
          pg8::EpiG2 E2{GT, MG};
#ifndef NO_G2
          pg8::gemm_phase<pg8::EpiG2, pg8::StaticOrder, true, true>(lds, g, S, E2);
#endif
        }
        PHASE_END();
        }
        { pg8::Gemm g{MG, (const bf16*)(p.ws + WS_WB3) + (size_t)l * DM * DM, MROWS, DM, DM}; pg8::StaticOrder S; S.init(MROWS, DM, G, (int)blockIdx.x);
          pg8::EpiG3 E3{l == 0 ? p.x_prompt : p.out + OUT_X, l == 0 ? p.x_sample : p.out + OUT_X + (size_t)M_CTX * DM, p.out + OUT_X,
                        (const float*)(p.ws + WS_GATEM) + (size_t)l * NMOD * DM, l + 1 < DEPTH ? (const float*)(p.ws + WS_WEFF) + (size_t)(l + 1) * NMOD * DM : nullptr,
                        AP, (float*)(p.ws + WS_SSP)};
#ifndef NO_G3
          pg8::gemm_phase<pg8::EpiG3, pg8::StaticOrder, true, true>(lds, g, S, E3);
#endif
        }
        if (l + 1 < DEPTH) PHASE_END();
    }
}

extern "C" void kernel_launch(void* const* d_in, const int* in_sizes, int n_in, void* d_out, int out_size, void* d_ws, size_t ws_size, hipStream_t stream) {
    static int grid = 0;
    if (grid == 0) {
        if (n_in != 23 || (size_t)out_size != OUT_TOTAL || ws_size < WS_END) { fprintf(stderr, "kernel_launch: unexpected shapes (n_in %d out %d ws %zu)\n", n_in, out_size, ws_size); grid = -1; return; }
        int dev = 0, cus = 0;
        if (hipGetDevice(&dev) != hipSuccess || hipDeviceGetAttribute(&cus, hipDeviceAttributeMultiprocessorCount, dev) != hipSuccess) { grid = -1; return; }
        if (hipFuncSetAttribute((const void*)fwd_kernel, hipFuncAttributeMaxDynamicSharedMemorySize, LDS_BYTES) != hipSuccess) { grid = -1; return; }
        (void)hipGetLastError();
        grid = cus;
        if (grid != 256) fprintf(stderr, "kernel_launch: %d CUs (built for 256)\n", grid);
    }
    if (grid < 0) return;
    if (hipMemsetAsync((char*)d_ws + WS_CTL, 0, CTL_ZERO_BYTES, stream) != hipSuccess) return;
    Args a{};
    const float** f = (const float**)&a.p;
    for (int i = 0; i < 23; ++i) f[i] = (const float*)d_in[i];
    a.p.out = (float*)d_out; a.p.ws = (unsigned char*)d_ws;
    hipLaunchKernelGGL(fwd_kernel, dim3(grid), dim3(512), LDS_BYTES, stream, a);
}
```
